# Optimizing an MI355X kernel written in HIP

```python
import math
import jax
import jax.numpy as jnp
from jax import lax
import numpy as np


D_MODEL = 1024
BATCH = 4
SEQ = 8192
DEPTH = 2

CTX_LEN = 256
GRID_W = 64
N_MIXERS = 2
N_S5_LAYERS = (DEPTH + N_MIXERS - 1) // N_MIXERS
N_MLA_LAYERS = DEPTH // N_MIXERS

S5_GROUP = 16
S5_GROUPS = D_MODEL // S5_GROUP
S5_STATE = 64
S5_CHUNK = 128
S5_DT_MIN = 0.001
S5_DT_MAX = 0.1

MLA_HEADS = D_MODEL // 128
MLA_NOPE = 128
MLA_ROPE = 64
MLA_V = 128
MLA_Q_RANK = 768
MLA_KV_RANK = 256
MLA_QK_DIM = MLA_NOPE + MLA_ROPE
ATTN_SCALE = 1.0 / math.sqrt(MLA_QK_DIM)
Q_BLOCK = 128
ROPE_BASE = 10000.0
ROPE_AXIS = MLA_ROPE // 2
ROPE_FREQS = ROPE_AXIS // 2

FFN_DIM = 2816
CONV_WIDTH = 3
EPS = 1e-6

kernel_name = 'hybrid_s5_mla_convffn_dit'


def rms_norm(x, g):
    xf = x.astype(jnp.float32)
    y = xf * lax.rsqrt(jnp.mean(xf * xf, axis=-1, keepdims=True) + EPS)
    return (y * g.astype(jnp.float32)).astype(x.dtype)


def adaln(cond, w, b):
    m = jax.nn.silu(cond.astype(jnp.float32)) @ w + b
    return jnp.split(m, 6, axis=-1)


def modulate(h, shift, scale):
    return h * (1.0 + scale) + shift


def s5_discretize(lam_re, lam_im, log_dt, b_re, b_im):
    lam_re = lam_re.astype(jnp.float32)
    lam_im = lam_im.astype(jnp.float32)
    dt = jnp.exp(log_dt.astype(jnp.float32))[:, None]
    mag = jnp.exp(lam_re * dt)
    ang = lam_im * dt
    ab_re = mag * jnp.cos(ang)
    ab_im = mag * jnp.sin(ang)
    den = lam_re * lam_re + lam_im * lam_im
    zr = ab_re - 1.0
    zi = ab_im
    fr = (zr * lam_re + zi * lam_im) / den
    fi = (zi * lam_re - zr * lam_im) / den
    b_re = b_re.astype(jnp.float32)
    b_im = b_im.astype(jnp.float32)
    bb_re = fr[..., None] * b_re - fi[..., None] * b_im
    bb_im = fr[..., None] * b_im + fi[..., None] * b_re
    return ab_re, ab_im, bb_re, bb_im


def _s5_combine(e1, e2):
    a1r, a1i, b1r, b1i = e1
    a2r, a2i, b2r, b2i = e2
    ar = a2r * a1r - a2i * a1i
    ai = a2r * a1i + a2i * a1r
    br = a2r * b1r - a2i * b1i + b2r
    bi = a2r * b1i + a2i * b1r + b2i
    return (ar, ai, br, bi)


def s5_scan(u, h0_re, h0_im, ab_re, ab_im, bb_re, bb_im, c_re, c_im):
    bsz, L, _ = u.shape
    n_chunks = L // S5_CHUNK
    uc = u.reshape(bsz, n_chunks, S5_CHUNK, S5_GROUPS, S5_GROUP).transpose(1, 0, 2, 3, 4)
    full = (bsz, S5_CHUNK, S5_GROUPS, S5_STATE)
    a_re = jnp.broadcast_to(ab_re, full)
    a_im = jnp.broadcast_to(ab_im, full)
    c_re = c_re.astype(jnp.float32)
    c_im = c_im.astype(jnp.float32)

    def chunk_step(carry, xc):
        hr, hi = carry
        bu_r = jnp.einsum('blgc,gpc->blgp', xc, bb_re)
        bu_i = jnp.einsum('blgc,gpc->blgp', xc, bb_im)
        pr, pi, sr, si = lax.associative_scan(_s5_combine, (a_re, a_im, bu_r, bu_i), axis=1)
        h_r = pr * hr[:, None] - pi * hi[:, None] + sr
        h_i = pr * hi[:, None] + pi * hr[:, None] + si
        y = jnp.einsum('blgp,gcp->blgc', h_r, c_re) - jnp.einsum('blgp,gcp->blgc', h_i, c_im)
        return (h_r[:, -1], h_i[:, -1]), y

    (hr, hi), ys = lax.scan(chunk_step, (h0_re, h0_im), uc)
    y = ys.transpose(1, 0, 2, 3, 4).reshape(bsz, L, D_MODEL)
    return y, hr, hi


def _maybe_flip(t, rev):
    return jnp.flip(t, axis=1) if rev else t


def s5_glu(y, glu_w, glu_b):
    z = jax.nn.gelu(y)
    a, g = jnp.split(z @ glu_w + glu_b, 2, axis=-1)
    return a * jax.nn.sigmoid(g)


def s5_mixer(h_lat, h_ctx, lam_re, lam_im, log_dt, b_re, b_im, c_re, c_im, d_skip, glu_w, glu_b, need_ctx):
    u_lat = h_lat.astype(jnp.float32)
    u_ctx = h_ctx.astype(jnp.float32)
    bsz = u_lat.shape[0]
    d32 = d_skip.astype(jnp.float32)
    y_lat = d32 * u_lat
    y_ctx = d32 * u_ctx
    zero = jnp.zeros((bsz, S5_GROUPS, S5_STATE), jnp.float32)
    for d in range(2):
        rev = d == 1
        ab_re, ab_im, bb_re, bb_im = s5_discretize(lam_re[d], lam_im[d], log_dt[d], b_re[d], b_im[d])
        yc, hr, hi = s5_scan(_maybe_flip(u_ctx, rev), zero, zero, ab_re, ab_im, bb_re, bb_im, c_re[d], c_im[d])
        yl, _, _ = s5_scan(_maybe_flip(u_lat, rev), hr, hi, ab_re, ab_im, bb_re, bb_im, c_re[d], c_im[d])
        y_lat = y_lat + _maybe_flip(yl, rev)
        if need_ctx:
            y_ctx = y_ctx + _maybe_flip(yc, rev)
    out_lat = s5_glu(y_lat, glu_w, glu_b).astype(h_lat.dtype)
    out_ctx = s5_glu(y_ctx, glu_w, glu_b).astype(h_ctx.dtype) if need_ctx else None
    return out_lat, out_ctx


def _rotate_half_block(x, cos, sin):
    x1 = x[..., :ROPE_FREQS]
    x2 = x[..., ROPE_FREQS:]
    return jnp.concatenate([x1 * cos - x2 * sin, x1 * sin + x2 * cos], axis=-1)


def axial_rope(x, cos_r, sin_r, cos_c, sin_c):
    return jnp.concatenate([_rotate_half_block(x[..., :ROPE_AXIS], cos_r, sin_r),
                            _rotate_half_block(x[..., ROPE_AXIS:], cos_c, sin_c)], axis=-1)


def mla_queries(h, w_dq, g_q, w_uq, g_qn, g_qr, rope):
    bsz, L, _ = h.shape
    q = (rms_norm(h @ w_dq, g_q) @ w_uq).reshape(bsz, L, MLA_HEADS, MLA_QK_DIM)
    q_nope = rms_norm(q[..., :MLA_NOPE], g_qn)
    q_rope = rms_norm(q[..., MLA_NOPE:], g_qr)
    if rope is not None:
        q_rope = axial_rope(q_rope, *rope)
    return jnp.concatenate([q_nope, q_rope], axis=-1)


def mla_keys_values(h, w_dkv, g_kv, w_ukv, g_kn, g_kr, rope):
    bsz, L, _ = h.shape
    kv = h @ w_dkv
    c_kv = rms_norm(kv[..., :MLA_KV_RANK], g_kv)
    k_rope = rms_norm(kv[..., MLA_KV_RANK:], g_kr)[:, :, None, :]
    if rope is not None:
        k_rope = axial_rope(k_rope, *rope)
    kvu = (c_kv @ w_ukv).reshape(bsz, L, MLA_HEADS, MLA_NOPE + MLA_V)
    k_nope = rms_norm(kvu[..., :MLA_NOPE], g_kn)
    v = kvu[..., MLA_NOPE:]
    k = jnp.concatenate([k_nope, jnp.broadcast_to(k_rope, (bsz, L, MLA_HEADS, MLA_ROPE))], axis=-1)
    return k, v


def block_attention(q, k, v):
    bsz, Lq = q.shape[0], q.shape[1]
    nb = Lq // Q_BLOCK
    qb = q.reshape(bsz, nb, Q_BLOCK, MLA_HEADS, MLA_QK_DIM).transpose(1, 0, 2, 3, 4)

    def one_block(qblk):
        s = jnp.einsum('bqhd,bkhd->bhqk', qblk, k).astype(jnp.float32) * ATTN_SCALE
        p = jax.nn.softmax(s, axis=-1).astype(v.dtype)
        return jnp.einsum('bhqk,bkhd->bqhd', p, v)

    o = lax.map(one_block, qb)
    return o.transpose(1, 0, 2, 3, 4).reshape(bsz, Lq, MLA_HEADS * MLA_V)


def mla_mixer(h_lat, h_ctx, w_dq, g_q, w_uq, w_dkv, g_kv, w_ukv, g_qn, g_qr, g_kn, g_kr, w_o, rope, need_ctx):
    k_ctx, v_ctx = mla_keys_values(h_ctx, w_dkv, g_kv, w_ukv, g_kn, g_kr, None)
    k_lat, v_lat = mla_keys_values(h_lat, w_dkv, g_kv, w_ukv, g_kn, g_kr, rope)
    q_lat = mla_queries(h_lat, w_dq, g_q, w_uq, g_qn, g_qr, rope)
    k_all = jnp.concatenate([k_ctx, k_lat], axis=1)
    v_all = jnp.concatenate([v_ctx, v_lat], axis=1)
    out_lat = block_attention(q_lat, k_all, v_all) @ w_o
    out_ctx = None
    if need_ctx:
        q_ctx = mla_queries(h_ctx, w_dq, g_q, w_uq, g_qn, g_qr, None)
        out_ctx = block_attention(q_ctx, k_ctx, v_ctx) @ w_o
    return out_lat, out_ctx


def conv_ffn(h, w_in, conv_w, conv_b, w_out):
    L = h.shape[1]
    a, b = jnp.split(h @ w_in, 2, axis=-1)
    pad = CONV_WIDTH // 2
    ap = jnp.pad(a, ((0, 0), (pad, pad), (0, 0)))
    conv = conv_b
    for t in range(CONV_WIDTH):
        conv = conv + ap[:, t:t + L] * conv_w[t]
    return (jax.nn.silu(conv) * b) @ w_out


def _normal(key, shape, scale):
    return scale * jax.random.normal(key, shape, jnp.float32)


def _gain(key, shape):
    return 1.0 + 0.05 * jax.random.normal(key, shape, jnp.float32)


def setup_inputs(seed: int = 0) -> dict:
    key = jax.random.key(seed)
    ks = jax.random.split(key, 33)
    D = D_MODEL
    s5_lam_shape = (N_S5_LAYERS, 2, S5_GROUPS, S5_STATE)
    n_idx = jnp.arange(S5_STATE, dtype=jnp.float32)
    return {
        'x': jax.random.normal(ks[0], (BATCH, SEQ, D), jnp.float32),
        'c': jax.random.normal(ks[1], (BATCH, D), jnp.float32),
        'ctx': jax.random.normal(ks[2], (BATCH, CTX_LEN, D), jnp.float32),
        'c_ctx': jax.random.normal(ks[3], (D,), jnp.float32),
        'ada_w': _normal(ks[4], (DEPTH, D, 6 * D), 0.5 * D ** -0.5),
        'ada_b': _normal(ks[5], (DEPTH, 6 * D), 0.01),
        'norm_mix': _gain(ks[6], (DEPTH, D)),
        'norm_ffn': _gain(ks[7], (DEPTH, D)),
        's5_lam_re': -0.5 + _normal(ks[8], s5_lam_shape, 0.01),
        's5_lam_im': jnp.pi * n_idx + _normal(ks[9], s5_lam_shape, 0.01),
        's5_log_dt': jax.random.uniform(ks[10], (N_S5_LAYERS, 2, S5_GROUPS), jnp.float32,
                                        minval=math.log(S5_DT_MIN), maxval=math.log(S5_DT_MAX)),
        's5_b_re': _normal(ks[11], (N_S5_LAYERS, 2, S5_GROUPS, S5_STATE, S5_GROUP), (2.0 * S5_GROUP) ** -0.5),
        's5_b_im': _normal(ks[12], (N_S5_LAYERS, 2, S5_GROUPS, S5_STATE, S5_GROUP), (2.0 * S5_GROUP) ** -0.5),
        's5_c_re': _normal(ks[13], (N_S5_LAYERS, 2, S5_GROUPS, S5_GROUP, S5_STATE), (2.0 * S5_STATE) ** -0.5),
        's5_c_im': _normal(ks[14], (N_S5_LAYERS, 2, S5_GROUPS, S5_GROUP, S5_STATE), (2.0 * S5_STATE) ** -0.5),
        's5_d': _normal(ks[15], (N_S5_LAYERS, D), 1.0),
        's5_glu_w': _normal(ks[16], (N_S5_LAYERS, D, 2 * D), D ** -0.5),
        's5_glu_b': _normal(ks[17], (N_S5_LAYERS, 2 * D), 0.01),
        'mla_w_dq': _normal(ks[18], (N_MLA_LAYERS, D, MLA_Q_RANK), D ** -0.5),
        'mla_g_q': _gain(ks[19], (N_MLA_LAYERS, MLA_Q_RANK)),
        'mla_w_uq': _normal(ks[20], (N_MLA_LAYERS, MLA_Q_RANK, MLA_HEADS * MLA_QK_DIM), MLA_Q_RANK ** -0.5),
        'mla_w_dkv': _normal(ks[21], (N_MLA_LAYERS, D, MLA_KV_RANK + MLA_ROPE), D ** -0.5),
        'mla_g_kv': _gain(ks[22], (N_MLA_LAYERS, MLA_KV_RANK)),
        'mla_w_ukv': _normal(ks[23], (N_MLA_LAYERS, MLA_KV_RANK, MLA_HEADS * (MLA_NOPE + MLA_V)), MLA_KV_RANK ** -0.5),
        'mla_g_qn': _gain(ks[24], (N_MLA_LAYERS, MLA_NOPE)),
        'mla_g_qr': _gain(ks[25], (N_MLA_LAYERS, MLA_ROPE)),
        'mla_g_kn': _gain(ks[26], (N_MLA_LAYERS, MLA_NOPE)),
        'mla_g_kr': _gain(ks[27], (N_MLA_LAYERS, MLA_ROPE)),
        'mla_w_o': _normal(ks[28], (N_MLA_LAYERS, MLA_HEADS * MLA_V, D), (MLA_HEADS * MLA_V) ** -0.5),
        'ffn_w_in': _normal(ks[29], (DEPTH, D, 2 * FFN_DIM), D ** -0.5),
        'ffn_conv_w': _normal(ks[30], (DEPTH, CONV_WIDTH, FFN_DIM), CONV_WIDTH ** -0.5),
        'ffn_conv_b': _normal(ks[31], (DEPTH, FFN_DIM), 0.01),
        'ffn_w_out': _normal(ks[32], (DEPTH, FFN_DIM, D), FFN_DIM ** -0.5),
    }


def reference(x, c, ctx, c_ctx, ada_w, ada_b, norm_mix, norm_ffn,
              s5_lam_re, s5_lam_im, s5_log_dt, s5_b_re, s5_b_im, s5_c_re, s5_c_im, s5_d, s5_glu_w, s5_glu_b,
              mla_w_dq, mla_g_q, mla_w_uq, mla_w_dkv, mla_g_kv, mla_w_ukv, mla_g_qn, mla_g_qr, mla_g_kn, mla_g_kr, mla_w_o,
              ffn_w_in, ffn_conv_w, ffn_conv_b, ffn_w_out):
    L = x.shape[1]
    ROWS = L // GRID_W
    rows = jnp.repeat(jnp.arange(ROWS, dtype=jnp.int32), GRID_W)
    cols = jnp.tile(jnp.arange(GRID_W, dtype=jnp.int32), ROWS)
    inv_freq = ROPE_BASE ** (-jnp.arange(ROPE_FREQS, dtype=jnp.float32) / ROPE_FREQS)
    ang_r = rows.astype(jnp.float32)[:, None] * inv_freq
    ang_c = cols.astype(jnp.float32)[:, None] * inv_freq
    rope = (jnp.cos(ang_r)[:, None, :], jnp.sin(ang_r)[:, None, :],
            jnp.cos(ang_c)[:, None, :], jnp.sin(ang_c)[:, None, :])

    for i in range(DEPTH):
        last = i == DEPTH - 1
        need_ctx = not last
        j = i // N_MIXERS
        sh_m, sc_m, g_m, sh_f, sc_f, g_f = adaln(c[:, None, :], ada_w[i], ada_b[i])
        csh_m, csc_m, cg_m, csh_f, csc_f, cg_f = adaln(c_ctx[None, None, :], ada_w[i], ada_b[i])
        hx = modulate(rms_norm(x, norm_mix[i]), sh_m, sc_m)
        hc = modulate(rms_norm(ctx, norm_mix[i]), csh_m, csc_m)
        if i % N_MIXERS == 0:
            y_lat, y_ctx = s5_mixer(hx, hc, s5_lam_re[j], s5_lam_im[j], s5_log_dt[j], s5_b_re[j], s5_b_im[j],
                                    s5_c_re[j], s5_c_im[j], s5_d[j], s5_glu_w[j], s5_glu_b[j], need_ctx)
        else:
            y_lat, y_ctx = mla_mixer(hx, hc, mla_w_dq[j], mla_g_q[j], mla_w_uq[j], mla_w_dkv[j], mla_g_kv[j],
                                     mla_w_ukv[j], mla_g_qn[j], mla_g_qr[j], mla_g_kn[j], mla_g_kr[j], mla_w_o[j],
                                     rope, need_ctx)
        x = x + g_m * y_lat
        hx = modulate(rms_norm(x, norm_ffn[i]), sh_f, sc_f)
        x = x + g_f * conv_ffn(hx, ffn_w_in[i], ffn_conv_w[i], ffn_conv_b[i], ffn_w_out[i])
        if need_ctx:
            ctx = ctx + cg_m * y_ctx
            hc = modulate(rms_norm(ctx, norm_ffn[i]), csh_f, csc_f)
            ctx = ctx + cg_f * conv_ffn(hc, ffn_w_in[i], ffn_conv_w[i], ffn_conv_b[i], ffn_w_out[i])
    return x
```

```cpp
#include <hip/hip_runtime.h>
#include <hip/hip_cooperative_groups.h>
#include <cstdio>
#include <cstdint>
namespace cg = cooperative_groups;

#ifndef ONE_LAUNCH
#define ONE_LAUNCH 1
#endif

typedef unsigned short bf16_t;
using bf16x8 = __attribute__((ext_vector_type(8))) short;
using s16x4  = __attribute__((ext_vector_type(4))) short;
using f32x16 = __attribute__((ext_vector_type(16))) float;
using f32x4  = __attribute__((ext_vector_type(4))) float;
using u32x4  = __attribute__((ext_vector_type(4))) unsigned;
using u32x2  = __attribute__((ext_vector_type(2))) unsigned;

#define DEVI __device__ __forceinline__
#define SBAR() __builtin_amdgcn_sched_barrier(0)

constexpr int DM = 1024, NB = 4, SEQL = 8192, CTXL = 256;
constexpr int NLAT = NB * SEQL;
constexpr int NCTX = NB * CTXL;
constexpr int NTOK = NLAT + NCTX;
constexpr int FF = 2816;
constexpr int KVL = SEQL + CTXL;
constexpr int NCHUNK = 264;
constexpr float EPSN = 1e-6f;
constexpr int LDS_BYTES = 67584 + 16;
constexpr int LDP = 1088;

constexpr size_t OFF_MOD   = 0;
constexpr size_t OFF_S5AB  = OFF_MOD + 245760;
constexpr size_t OFF_ROPE  = OFF_S5AB + 131072;
constexpr size_t OFF_BBF   = OFF_ROPE + 16384;
constexpr size_t OFF_CMF   = OFF_BBF + 524288;
constexpr size_t OFF_WGLU  = OFF_CMF + 524288;
constexpr size_t OFF_WFIN  = OFF_WGLU + 4456448;
constexpr size_t WFIN_BYTES = 12255232;
constexpr size_t OFF_WFOUT = OFF_WFIN + 2 * WFIN_BYTES;
constexpr size_t OFF_WD    = OFF_WFOUT + 2 * 5767168;
constexpr size_t OFF_WUQ   = OFF_WD + 2506752;
constexpr size_t OFF_WUKV  = OFF_WUQ + 2359296;
constexpr size_t OFF_WO    = OFF_WUKV + 1048576;
constexpr size_t OFF_SSQ   = OFF_WO + 2228224;
constexpr size_t OFF_CTXR  = OFF_SSQ + 1081344;
constexpr size_t OFF_ACTA  = OFF_CTXR + 4194304;
constexpr size_t OFF_ACTB  = OFF_ACTA + 73531392;
constexpr size_t OFF_Y     = OFF_ACTB + 73531392;
constexpr size_t OFF_X     = OFF_Y + 77856768;
constexpr size_t OFF_K     = OFF_X + 100663296;
constexpr size_t OFF_BAR   = OFF_X + 204472320;
constexpr size_t WS_END    = OFF_BAR + 16384;

struct Params {
  const float* in[33];
  float* out;
  unsigned char* ws;
  int pad0, pad1;
};

DEVI unsigned cvtpk(float lo, float hi) { unsigned r; asm("v_cvt_pk_bf16_f32 %0, %1, %2" : "=v"(r) : "v"(lo), "v"(hi)); return r; }
DEVI bf16_t f2bf(float x) { return (bf16_t)(cvtpk(x, 0.f) & 0xffffu); }
DEVI float bf2f(bf16_t b) { return __uint_as_float(((unsigned)b) << 16); }
DEVI int tid_() { int t = threadIdx.x; asm volatile("" : "+v"(t)); return t; }
DEVI int crow(int r, int hi) { return (r & 3) + 8 * (r >> 2) + 4 * hi; }
DEVI float wave_sum(float v) {
#pragma unroll
  for (int o = 32; o; o >>= 1) v += __shfl_xor(v, o);
  return v;
}
DEVI float sigmoidf_(float x) { return 1.f / (1.f + __expf(-x)); }
DEVI float gelu_tanh(float x) {
  float u = 0.7978845608028654f * (x + 0.044715f * x * x * x);
  float t = 1.f - 2.f / (1.f + __expf(2.f * u));
  return 0.5f * x * (1.f + t);
}

DEVI int permrow(int perm, int n) {
  if (perm == 1) { int g = n >= 1024; int j = g ? n - 1024 : n; return (j >> 5) * 64 + g * 32 + (j & 31); }
  if (perm == 2) { int g = n >= FF; int j = g ? n - FF : n; return (j >> 5) * 64 + g * 32 + (j & 31); }
  if (perm == 3) { int h = n / 192, d = n - h * 192; return d < 128 ? h * 128 + d : 1024 + h * 64 + (d - 128); }
  return n;
}

DEVI void prep_transpose(int t, const float* src, int K, int N, bf16_t* dst, int ld, int perm, const float* scale, char* lds) {
  const int tid = tid_();
  float* tl = (float*)lds;
  const int ntn = N >> 6;
  const int tk = t / ntn, tn = t - tk * ntn;
  const int k0 = tk * 64, n0 = tn * 64;
#pragma unroll
  for (int e = 0; e < 16; ++e) {
    int idx = e * 256 + tid, i = idx >> 6, j = idx & 63;
    float v = src[(size_t)(k0 + i) * N + n0 + j];
    if (scale) v *= scale[k0 + i];
    tl[i * 65 + j] = v;
  }
  __syncthreads();
#pragma unroll
  for (int e = 0; e < 8; ++e) {
    int idx = e * 256 + tid, j = idx >> 5, ip = idx & 31;
    unsigned w = cvtpk(tl[(2 * ip) * 65 + j], tl[(2 * ip + 1) * 65 + j]);
    int nr = permrow(perm, n0 + j);
    *(unsigned*)(dst + (size_t)nr * ld + k0 + 2 * ip) = w;
  }
  __syncthreads();
}

constexpr int T_ADA = 384, T_TR = 5680, T_S5 = 32;
constexpr int T_TOTAL = T_ADA + T_TR + T_S5 + 2;

DEVI void phase_prep(const Params& p, char* lds) {
  const int tid = tid_();
  unsigned char* ws = p.ws;
  for (int idx = blockIdx.x; idx < T_TOTAL; idx += gridDim.x) {
    if (idx < T_ADA) {
      float* sl = (float*)lds;
      float* red = sl + 5 * 1024;
      for (int e = tid; e < 5 * 1024; e += 256) {
        int r = e >> 10, k = e & 1023;
        float c = r < 4 ? p.in[1][r * 1024 + k] : p.in[3][k];
        sl[e] = c * sigmoidf_(c);
      }
      __syncthreads();
      const int layer = idx / 192, cg_ = idx - layer * 192;
      const int cl = tid & 31, ks = tid >> 5;
      const int col = cg_ * 32 + cl;
      const float* w = p.in[4] + (size_t)layer * 1024 * 6144 + col;
      float a0 = 0, a1 = 0, a2 = 0, a3 = 0, a4 = 0;
#pragma unroll 8
      for (int k = ks * 128; k < ks * 128 + 128; ++k) {
        float wv = w[(size_t)k * 6144];
        a0 += sl[k] * wv; a1 += sl[1024 + k] * wv; a2 += sl[2048 + k] * wv; a3 += sl[3072 + k] * wv; a4 += sl[4096 + k] * wv;
      }
      red[(ks * 5 + 0) * 32 + cl] = a0; red[(ks * 5 + 1) * 32 + cl] = a1; red[(ks * 5 + 2) * 32 + cl] = a2;
      red[(ks * 5 + 3) * 32 + cl] = a3; red[(ks * 5 + 4) * 32 + cl] = a4;
      __syncthreads();
      if (tid < 160) {
        int r = tid >> 5, c2 = tid & 31;
        float s = 0;
#pragma unroll
        for (int q = 0; q < 8; ++q) s += red[(q * 5 + r) * 32 + c2];
        int cc = cg_ * 32 + c2;
        ((float*)(ws + OFF_MOD))[(layer * 5 + r) * 6144 + cc] = s + p.in[5][layer * 6144 + cc];
      }
      __syncthreads();
    } else if (idx < T_ADA + T_TR) {
      int t = idx - T_ADA;
      const float* tsrc; int tK, tN, tperm; bf16_t* tdst; const float* tscale = nullptr;
      if (t < 512) { tsrc = p.in[16]; tK = 1024; tN = 2048; tdst = (bf16_t*)(ws + OFF_WGLU); tperm = 1; }
      else if ((t -= 512) < 1408) { tsrc = p.in[29]; tK = 1024; tN = 5632; tdst = (bf16_t*)(ws + OFF_WFIN); tperm = 2; }
      else if ((t -= 1408) < 1408) { tsrc = p.in[29] + (size_t)1024 * 5632; tK = 1024; tN = 5632; tdst = (bf16_t*)(ws + OFF_WFIN + WFIN_BYTES); tperm = 2; }
      else if ((t -= 1408) < 704) { tsrc = p.in[32]; tK = 2816; tN = 1024; tdst = (bf16_t*)(ws + OFF_WFOUT); tperm = 0; }
      else if ((t -= 704) < 704) { tsrc = p.in[32] + (size_t)2816 * 1024; tK = 2816; tN = 1024; tdst = (bf16_t*)(ws + OFF_WFOUT + 5767168); tperm = 0; }
      else if ((t -= 704) < 192) { tsrc = p.in[18]; tK = 1024; tN = 768; tdst = (bf16_t*)(ws + OFF_WD); tperm = 0; }
      else if ((t -= 192) < 80) { tsrc = p.in[21]; tK = 1024; tN = 320; tdst = (bf16_t*)(ws + OFF_WD) + (size_t)768 * LDP; tperm = 0; }
      else if ((t -= 80) < 288) { tsrc = p.in[20]; tK = 768; tN = 1536; tdst = (bf16_t*)(ws + OFF_WUQ); tperm = 3; tscale = p.in[19]; }
      else if ((t -= 288) < 128) { tsrc = p.in[23]; tK = 256; tN = 2048; tdst = (bf16_t*)(ws + OFF_WUKV); tperm = 0; tscale = p.in[22]; }
      else { t -= 128; tsrc = p.in[28]; tK = 1024; tN = 1024; tdst = (bf16_t*)(ws + OFF_WO); tperm = 0; }
      prep_transpose(t, tsrc, tK, tN, tdst, tK == 1024 ? LDP : tK, tperm, tscale, lds);
    } else if (idx < T_ADA + T_TR + T_S5) {
      const int gid = (idx - T_ADA - T_TR) * 256 + tid;
      const int pp = gid & 63, dg = gid >> 6;
      const double dt = exp((double)p.in[10][dg]);
      const double lre = p.in[8][gid], lim = p.in[9][gid];
      const double mag = exp(lre * dt), ang = lim * dt;
      const double are = mag * cos(ang), aim = mag * sin(ang);
      const double den = lre * lre + lim * lim;
      const double zr = are - 1.0, zi = aim;
      const double fr = (zr * lre + zi * lim) / den, fi = (zi * lre - zr * lim) / den;
      double tr = are, ti = aim;
#pragma unroll
      for (int q = 0; q < 5; ++q) { double nr = tr * tr - ti * ti, ni = 2.0 * tr * ti; tr = nr; ti = ni; }
      float* tab = (float*)(ws + OFF_S5AB);
      tab[gid] = (float)are; tab[8192 + gid] = (float)aim; tab[16384 + gid] = (float)tr; tab[24576 + gid] = (float)ti;
      bf16_t* bbf = (bf16_t*)(ws + OFF_BBF);
      bf16_t* cmf = (bf16_t*)(ws + OFF_CMF);
      for (int c = 0; c < 16; ++c) {
        const double bre = p.in[11][(size_t)gid * 16 + c], bim = p.in[12][(size_t)gid * 16 + c];
        const float bbr = (float)(fr * bre - fi * bim), bbi = (float)(fr * bim + fi * bre);
        const int h = c >> 3, jj = c & 7, lane = h * 32 + (pp & 31);
        bbf[((size_t)(dg * 4 + (pp >> 5)) * 64 + lane) * 8 + jj] = f2bf(bbr);
        bbf[((size_t)(dg * 4 + 2 + (pp >> 5)) * 64 + lane) * 8 + jj] = f2bf(bbi);
        const float cre = p.in[13][((size_t)dg * 16 + c) * 64 + pp], cim = p.in[14][((size_t)dg * 16 + c) * 64 + pp];
        const int ks = pp >> 5, q = (pp & 31) >> 3, j2 = pp & 7, lane2 = q * 16 + c;
        cmf[((size_t)(dg * 4 + ks) * 64 + lane2) * 8 + j2] = f2bf(cre);
        cmf[((size_t)(dg * 4 + 2 + ks) * 64 + lane2) * 8 + j2] = f2bf(-cim);
      }
    } else if (idx == T_ADA + T_TR + T_S5) {
      float* rt = (float*)(ws + OFF_ROPE);
      for (int e = tid; e < 2048; e += 256) {
        int pos = e >> 4, i = e & 15;
        float inv = (float)pow(10000.0, -(double)i / 16.0);
        float ang = (float)pos * inv;
        rt[e * 2] = (float)cos((double)ang); rt[e * 2 + 1] = (float)sin((double)ang);
      }
    } else {
      u32x4 z = {0, 0, 0, 0};
      u32x4* d = (u32x4*)((bf16_t*)(ws + OFF_WD) + (size_t)1088 * LDP);
      for (int e = tid; e < 64 * LDP / 8; e += 256) d[e] = z;
    }
  }
}

DEVI void phase_norm(const Params& p, const float* src_lat, const float* src_ctx, const float* gn, int layer, int sh_idx, int sc_idx, int nrows) {
  const int lane = tid_() & 63, wid = tid_() >> 6;
  const float* mod = (const float*)(p.ws + OFF_MOD);
  bf16_t* dst = (bf16_t*)(p.ws + OFF_ACTA);
  for (int row = blockIdx.x * 4 + wid; row < nrows; row += gridDim.x * 4) {
    const float* s; int mr;
    if (row < NLAT) { s = src_lat + (size_t)row * DM; mr = row >> 13; } else { s = src_ctx + (size_t)(row - NLAT) * DM; mr = 4; }
    f32x4 v[4]; float ss = 0;
#pragma unroll
    for (int i = 0; i < 4; ++i) { v[i] = *(const f32x4*)(s + i * 256 + lane * 4); ss += v[i][0] * v[i][0] + v[i][1] * v[i][1] + v[i][2] * v[i][2] + v[i][3] * v[i][3]; }
    ss = wave_sum(ss);
    const float rs = rsqrtf(ss * (1.f / DM) + EPSN);
    const float* shp = mod + (layer * 5 + mr) * 6144 + sh_idx * 1024;
    const float* scp = mod + (layer * 5 + mr) * 6144 + sc_idx * 1024;
    f32x4 gg[4], shh[4], scc[4];
#pragma unroll
    for (int i = 0; i < 4; ++i) { const int c = i * 256 + lane * 4; gg[i] = *(const f32x4*)(gn + c); shh[i] = *(const f32x4*)(shp + c); scc[i] = *(const f32x4*)(scp + c); }
#pragma unroll
    for (int i = 0; i < 4; ++i) {
      const int c = i * 256 + lane * 4;
      float o0 = (v[i][0] * rs * gg[i][0]) * (1.f + scc[i][0]) + shh[i][0];
      float o1 = (v[i][1] * rs * gg[i][1]) * (1.f + scc[i][1]) + shh[i][1];
      float o2 = (v[i][2] * rs * gg[i][2]) * (1.f + scc[i][2]) + shh[i][2];
      float o3 = (v[i][3] * rs * gg[i][3]) * (1.f + scc[i][3]) + shh[i][3];
      u32x2 w = {cvtpk(o0, o1), cvtpk(o2, o3)};
      *(u32x2*)(dst + (size_t)row * LDP + c) = w;
    }
  }
}

template <bool PHASE_C>
DEVI void phase_s5(const Params& p, char* lds) {
  const int lane = tid_() & 63, wid = tid_() >> 6, r32 = lane & 31, hi = lane >> 5;
  float* wl = (float*)(lds + wid * 16896);
  const bf16_t* U = (const bf16_t*)(p.ws + OFF_ACTA);
  bf16_t* Z = (bf16_t*)(p.ws + OFF_ACTB);
  const float* tab = (const float*)(p.ws + OFF_S5AB);
  const bf16x8* bbf = (const bf16x8*)(p.ws + OFF_BBF);
  const bf16x8* cmf = (const bf16x8*)(p.ws + OFF_CMF);
  float* S = (float*)(p.ws + OFF_Y);
  for (int pc = blockIdx.x * 4 + wid; pc < NB * 64 * 8; pc += gridDim.x * 4) {
    const int pair = pc >> 3, sub = pc & 7, b = pair >> 6, g = pair & 63;
    bf16x8 bb[2][4], cm[2][4];
    float arr[2], aii[2];
#pragma unroll
    for (int d = 0; d < 2; ++d) {
      const int dg = d * 64 + g;
#pragma unroll
      for (int nt = 0; nt < 4; ++nt) bb[d][nt] = bbf[(size_t)(dg * 4 + nt) * 64 + lane];
      if (PHASE_C) {
#pragma unroll
        for (int ks = 0; ks < 4; ++ks) cm[d][ks] = cmf[(size_t)(dg * 4 + ks) * 64 + lane];
      }
      arr[d] = tab[dg * 64 + lane]; aii[d] = tab[8192 + dg * 64 + lane];
    }
    const float dsk = PHASE_C ? p.in[15][g * 16 + (lane & 15)] : 0.f;
   for (int kc = sub; kc < NCHUNK; kc += 8) {
    const int tok0 = kc < 256 ? b * SEQL + kc * 32 : NLAT + b * CTXL + (kc - 256) * 32;
    const bf16x8 afrag = *(const bf16x8*)(U + (size_t)(tok0 + r32) * LDP + g * 16 + hi * 8);
    f32x4 y0 = {0, 0, 0, 0}, y1 = {0, 0, 0, 0};
#pragma unroll
    for (int d = 0; d < 2; ++d) {
      const int j = kc < 256 ? (d ? 8 + 255 - kc : 8 + kc) : (d ? 7 - (kc - 256) : (kc - 256));
#pragma unroll
      for (int nt = 0; nt < 4; ++nt) {
        f32x16 acc = {};
        acc = __builtin_amdgcn_mfma_f32_32x32x16_bf16(afrag, bb[d][nt], acc, 0, 0, 0);
#pragma unroll
        for (int i = 0; i < 16; ++i) wl[crow(i, hi) * 132 + nt * 32 + r32] = acc[i];
      }
      asm volatile("s_waitcnt lgkmcnt(0)" ::: "memory");
      const float ar = arr[d], ai = aii[d];
      float hr = 0.f, him = 0.f;
      float* sp = S + ((size_t)((b * 2 + d) * 64 + g) * NCHUNK + j) * 128;
      if (PHASE_C) { hr = sp[lane]; him = sp[64 + lane]; }
      float bur[32], bui[32];
#pragma unroll
      for (int s = 0; s < 32; ++s) { bur[s] = wl[s * 132 + lane]; bui[s] = wl[s * 132 + 64 + lane]; }
#pragma unroll
      for (int s = 0; s < 32; ++s) {
        const int t = d ? 31 - s : s;
        const float nr = ar * hr - ai * him + bur[t];
        const float ni = ar * him + ai * hr + bui[t];
        hr = nr; him = ni;
        if (PHASE_C) { bur[t] = hr; bui[t] = him; }
      }
      if (PHASE_C) {
#pragma unroll
        for (int s = 0; s < 32; ++s) { wl[s * 132 + lane] = bur[s]; wl[s * 132 + 64 + lane] = bui[s]; }
      }
      if (!PHASE_C) { sp[lane] = hr; sp[64 + lane] = him; }
      if (PHASE_C) {
        asm volatile("s_waitcnt lgkmcnt(0)" ::: "memory");
#pragma unroll
        for (int ks = 0; ks < 4; ++ks) {
          const bf16x8 cf = cm[d][ks];
          const float* a0p = wl + (lane & 15) * 132 + ks * 32 + (lane >> 4) * 8;
          const f32x4 a00 = *(const f32x4*)a0p, a01 = *(const f32x4*)(a0p + 4);
          const f32x4 a10 = *(const f32x4*)(a0p + 16 * 132), a11 = *(const f32x4*)(a0p + 16 * 132 + 4);
          u32x4 w0 = {cvtpk(a00[0], a00[1]), cvtpk(a00[2], a00[3]), cvtpk(a01[0], a01[1]), cvtpk(a01[2], a01[3])};
          u32x4 w1 = {cvtpk(a10[0], a10[1]), cvtpk(a10[2], a10[3]), cvtpk(a11[0], a11[1]), cvtpk(a11[2], a11[3])};
          y0 = __builtin_amdgcn_mfma_f32_16x16x32_bf16(*(bf16x8*)&w0, cf, y0, 0, 0, 0);
          y1 = __builtin_amdgcn_mfma_f32_16x16x32_bf16(*(bf16x8*)&w1, cf, y1, 0, 0, 0);
        }
        asm volatile("s_waitcnt lgkmcnt(0)" ::: "memory");
      }
    }
    if (PHASE_C) {
      const int c = lane & 15, ch = g * 16 + c;
      float u0[4], u1[4];
#pragma unroll
      for (int r = 0; r < 4; ++r) {
        const int t0 = (lane >> 4) * 4 + r;
        u0[r] = bf2f(U[(size_t)(tok0 + t0) * LDP + ch]); u1[r] = bf2f(U[(size_t)(tok0 + 16 + t0) * LDP + ch]);
      }
#pragma unroll
      for (int r = 0; r < 4; ++r) {
        const int t0 = (lane >> 4) * 4 + r;
        Z[(size_t)(tok0 + t0) * LDP + ch] = f2bf(gelu_tanh(y0[r] + dsk * u0[r]));
        Z[(size_t)(tok0 + 16 + t0) * LDP + ch] = f2bf(gelu_tanh(y1[r] + dsk * u1[r]));
      }
    }
   }
  }
}

DEVI void phase_s5_state(const Params& p) {
  const int lane = tid_() & 63, wid = tid_() >> 6, r32 = lane & 31, hi = lane >> 5;
  const bf16_t* U = (const bf16_t*)(p.ws + OFF_ACTA);
  const float* tab = (const float*)(p.ws + OFF_S5AB);
  const bf16x8* bbf = (const bf16x8*)(p.ws + OFF_BBF);
  float* S = (float*)(p.ws + OFF_Y);
  for (int pc = blockIdx.x * 4 + wid; pc < NB * 64 * 8; pc += gridDim.x * 4) {
    const int pair = pc >> 3, sub = pc & 7, b = pair >> 6, g = pair & 63;
    bf16x8 bb[2][4];
    float lr_[2][2], li_[2][2], pr_[2][2], pi_[2][2], qr_[2][2], qi_[2][2];
#pragma unroll
    for (int d = 0; d < 2; ++d) {
      const int dg = d * 64 + g;
#pragma unroll
      for (int nt = 0; nt < 4; ++nt) bb[d][nt] = bbf[(size_t)(dg * 4 + nt) * 64 + lane];
#pragma unroll
      for (int st = 0; st < 2; ++st) {
        const float ar = tab[dg * 64 + st * 32 + r32], ai = tab[8192 + dg * 64 + st * 32 + r32];
        const float a2r = ar * ar - ai * ai, a2i = 2.f * ar * ai;
        const float a4r = a2r * a2r - a2i * a2i, a4i = 2.f * a2r * a2i;
        lr_[d][st] = ar; li_[d][st] = ai;
        const bool post = (hi == d);
        pr_[d][st] = post ? 1.f : a4r; pi_[d][st] = post ? 0.f : a4i;
        qr_[d][st] = post ? a4r : 1.f; qi_[d][st] = post ? a4i : 0.f;
      }
    }
    for (int kc = sub; kc < NCHUNK; kc += 8) {
      const int tok0 = kc < 256 ? b * SEQL + kc * 32 : NLAT + b * CTXL + (kc - 256) * 32;
      const bf16x8 afrag = *(const bf16x8*)(U + (size_t)(tok0 + r32) * LDP + g * 16 + hi * 8);
#pragma unroll
      for (int d = 0; d < 2; ++d) {
        const int j = kc < 256 ? (d ? 8 + 255 - kc : 8 + kc) : (d ? 7 - (kc - 256) : (kc - 256));
        float* sp = S + ((size_t)((b * 2 + d) * 64 + g) * NCHUNK + j) * 128;
#pragma unroll
        for (int st = 0; st < 2; ++st) {
          f32x16 acr = {}, aci = {};
          acr = __builtin_amdgcn_mfma_f32_32x32x16_bf16(afrag, bb[d][st], acr, 0, 0, 0);
          aci = __builtin_amdgcn_mfma_f32_32x32x16_bf16(afrag, bb[d][st + 2], aci, 0, 0, 0);
          const float ar = lr_[d][st], ai = li_[d][st];
          float hr = 0.f, him = 0.f;
#pragma unroll
          for (int g4 = 0; g4 < 4; ++g4) {
            const int G = d ? 3 - g4 : g4;
            { const float nr = pr_[d][st] * hr - pi_[d][st] * him, ni = pr_[d][st] * him + pi_[d][st] * hr; hr = nr; him = ni; }
#pragma unroll
            for (int jj = 0; jj < 4; ++jj) {
              const int i = G * 4 + (d ? 3 - jj : jj);
              const float nr = ar * hr - ai * him + acr[i];
              const float ni = ar * him + ai * hr + aci[i];
              hr = nr; him = ni;
            }
            { const float nr = qr_[d][st] * hr - qi_[d][st] * him, ni = qr_[d][st] * him + qi_[d][st] * hr; hr = nr; him = ni; }
          }
          { auto rr = __builtin_amdgcn_permlane32_swap(__float_as_uint(hr), __float_as_uint(hr), false, false);
            hr = __uint_as_float(rr[0]) + __uint_as_float(rr[1]); }
          { auto rr = __builtin_amdgcn_permlane32_swap(__float_as_uint(him), __float_as_uint(him), false, false);
            him = __uint_as_float(rr[0]) + __uint_as_float(rr[1]); }
          if (hi == st) { sp[st * 32 + r32] = hr; sp[64 + st * 32 + r32] = him; }
        }
      }
    }
  }
}

DEVI void phase_s5_carry(const Params& p) {
  const int lane = tid_() & 63, wid = tid_() >> 6;
  const float* tab = (const float*)(p.ws + OFF_S5AB);
  float* S = (float*)(p.ws + OFF_Y);
  for (int task = blockIdx.x * 4 + wid; task < NB * 2 * 64; task += gridDim.x * 4) {
    const int g = task & 63, d = (task >> 6) & 1;
    const float lr = tab[16384 + (d * 64 + g) * 64 + lane], li = tab[24576 + (d * 64 + g) * 64 + lane];
    float* sp = S + (size_t)task * NCHUNK * 128;
    float hr = 0.f, him = 0.f;
    float tr[8], ti[8], ur[8], ui[8];
#pragma unroll
    for (int q = 0; q < 8; ++q) { tr[q] = sp[q * 128 + lane]; ti[q] = sp[q * 128 + 64 + lane]; }
    for (int j0 = 0; j0 < NCHUNK; j0 += 8) {
      if (j0 + 8 < NCHUNK) {
#pragma unroll
        for (int q = 0; q < 8; ++q) { ur[q] = sp[(j0 + 8 + q) * 128 + lane]; ui[q] = sp[(j0 + 8 + q) * 128 + 64 + lane]; }
      }
#pragma unroll
      for (int q = 0; q < 8; ++q) {
        sp[(j0 + q) * 128 + lane] = hr; sp[(j0 + q) * 128 + 64 + lane] = him;
        const float nr = lr * hr - li * him + tr[q];
        const float ni = lr * him + li * hr + ti[q];
        hr = nr; him = ni;
      }
#pragma unroll
      for (int q = 0; q < 8; ++q) { tr[q] = ur[q]; ti[q] = ui[q]; }
    }
  }
}

constexpr float QSCALE = 0.07216878364870322f * 1.4426950408889634f;
enum { EPI_GLU = 0, EPI_RES = 1, EPI_FFNIN = 2, EPI_G1 = 3, EPI_Q = 4, EPI_KV = 5 };

DEVI void rope64(float* v, const float* rt, int t) {
  const float* rr = rt + (t >> 6) * 32;
  const float* rc = rt + (t & 63) * 32;
#pragma unroll
  for (int i = 0; i < 16; ++i) {
    float c = rr[i * 2], s = rr[i * 2 + 1], x1 = v[i], x2 = v[16 + i];
    v[i] = x1 * c - x2 * s; v[16 + i] = x1 * s + x2 * c;
    c = rc[i * 2]; s = rc[i * 2 + 1]; x1 = v[32 + i]; x2 = v[48 + i];
    v[32 + i] = x1 * c - x2 * s; v[48 + i] = x1 * s + x2 * c;
  }
}
DEVI void store64bf(bf16_t* dst, const float* v) {
#pragma unroll
  for (int c = 0; c < 64; c += 8) {
    u32x4 w = {cvtpk(v[c], v[c + 1]), cvtpk(v[c + 2], v[c + 3]), cvtpk(v[c + 4], v[c + 5]), cvtpk(v[c + 6], v[c + 7])};
    *(u32x4*)(dst + c) = w;
  }
}

template <int EPI, bool GUARD>
DEVI void gemm_tile(const Params& p, const bf16_t* __restrict__ A, int lda, const bf16_t* __restrict__ Bt, int ldb, int K,
                          int row_base, int row_lo, int row_hi, int tile_n, int layer, int which, char* lds) {
  const int tid = tid_(), lane = tid & 63, wid = tid >> 6, wr = wid >> 1, wc = wid & 1, c16 = lane & 15, q4 = lane >> 4;
  f32x4 acc[4][4] = {};
  const int wq = __builtin_amdgcn_readfirstlane(wid) * 4;
  const int lrow = lane >> 3, lcp = lane & 7;
  const bf16_t* Agp[4]; const bf16_t* Bgp[4];
#pragma unroll
  for (int e = 0; e < 4; ++e) {
    const int r = (wq + e) * 8 + lrow;
    const int kc = lcp ^ ((r >> 1) & 7);
    int gr = row_base + r;
    if (GUARD) gr = gr < row_lo ? row_lo : (gr >= row_hi ? row_hi - 1 : gr);
    Agp[e] = A + (long)gr * lda + kc * 8;
    Bgp[e] = Bt + (long)(tile_n * 128 + r) * ldb + kc * 8;
  }
#define GISSUE(k0, buf) do { _Pragma("unroll") for (int e = 0; e < 4; ++e) { \
      __builtin_amdgcn_global_load_lds((const unsigned*)(Agp[e] + (k0)), (unsigned*)(lds + (buf) * 32768 + (wq + e) * 1024), 16, 0, 0); \
      __builtin_amdgcn_global_load_lds((const unsigned*)(Bgp[e] + (k0)), (unsigned*)(lds + (buf) * 32768 + 16384 + (wq + e) * 1024), 16, 0, 0); } } while (0)
  const int swz = c16 >> 1;
  int koff[2];
#pragma unroll
  for (int ks = 0; ks < 2; ++ks) koff[ks] = ((ks * 4 + q4) ^ swz) << 4;
  const int arow = (wr * 64 + c16) * 128, brow = 16384 + (wc * 64 + c16) * 128;
#define KSTEPS(buf) do { const char* Lb = lds + (buf) * 32768; _Pragma("unroll") for (int ks = 0; ks < 2; ++ks) { \
      bf16x8 af[4], bfr[4]; \
      _Pragma("unroll") for (int t = 0; t < 4; ++t) { af[t] = *(const bf16x8*)(Lb + arow + t * 2048 + koff[ks]); bfr[t] = *(const bf16x8*)(Lb + brow + t * 2048 + koff[ks]); } \
      _Pragma("unroll") for (int mt = 0; mt < 4; ++mt) _Pragma("unroll") for (int nt = 0; nt < 4; ++nt) \
        acc[mt][nt] = __builtin_amdgcn_mfma_f32_16x16x32_bf16(af[mt], bfr[nt], acc[mt][nt], 0, 0, 0); } } while (0)
#define GBAR() do { asm volatile("s_waitcnt vmcnt(0) lgkmcnt(0)" ::: "memory"); __builtin_amdgcn_s_barrier(); } while (0)
  GISSUE(0, 0); GBAR();
  for (int k0 = 0; k0 < K; k0 += 128) {
    GISSUE(k0 + 64, 1);
    KSTEPS(0);
    GBAR();
    if (k0 + 128 < K) GISSUE(k0 + 128, 0);
    KSTEPS(1);
    GBAR();
  }
#undef GISSUE
#undef KSTEPS
#undef GBAR
  const float* mod = (const float*)(p.ws + OFF_MOD);
  float* ctxr = (float*)(p.ws + OFF_CTXR);
  if (EPI == EPI_GLU) {
    const float* gb = p.in[17];
    const int j0 = tile_n * 64 + wc * 32 + c16;
    const bool lat = row_base < NLAT;
    const float* mg = mod + (lat ? (row_base >> 13) : 4) * 6144 + 2048;
    const float ba0 = gb[j0], ba1 = gb[j0 + 16], bg0 = gb[1024 + j0], bg1 = gb[1024 + j0 + 16], gt0 = mg[j0], gt1 = mg[j0 + 16];
    const float* xin = (lat ? p.in[0] + (size_t)row_base * DM : p.in[2] + (size_t)(row_base - NLAT) * DM) + j0;
    float* xo = (lat ? p.out + (size_t)row_base * DM : ctxr + (size_t)(row_base - NLAT) * DM) + j0;
#pragma unroll
    for (int mh = 0; mh < 2; ++mh) {
      float xv[2][2][4];
#pragma unroll
      for (int m2 = 0; m2 < 2; ++m2)
#pragma unroll
        for (int jj = 0; jj < 4; ++jj) { const size_t ro = (size_t)(wr * 64 + (mh * 2 + m2) * 16 + q4 * 4 + jj) * DM; xv[m2][0][jj] = xin[ro]; xv[m2][1][jj] = xin[ro + 16]; }
#pragma unroll
      for (int m2 = 0; m2 < 2; ++m2)
#pragma unroll
        for (int jj = 0; jj < 4; ++jj) {
          const int mt = mh * 2 + m2; const size_t ro = (size_t)(wr * 64 + mt * 16 + q4 * 4 + jj) * DM;
          xo[ro] = xv[m2][0][jj] + gt0 * ((acc[mt][0][jj] + ba0) * sigmoidf_(acc[mt][2][jj] + bg0));
          xo[ro + 16] = xv[m2][1][jj] + gt1 * ((acc[mt][1][jj] + ba1) * sigmoidf_(acc[mt][3][jj] + bg1));
        }
    }
    return;
  }
  if (EPI == EPI_RES) {
    const bool lat = row_base < NLAT;
    const float* gp = mod + (layer * 5 + (lat ? (row_base >> 13) : 4)) * 6144 + which * 1024 + tile_n * 128 + wc * 64 + c16;
    const float g0 = gp[0], g1 = gp[16], g2 = gp[32], g3 = gp[48];
    float* xo = (lat ? p.out + (size_t)row_base * DM : ctxr + (size_t)(row_base - NLAT) * DM) + tile_n * 128 + wc * 64 + c16;
#pragma unroll
    for (int mh = 0; mh < 2; ++mh) {
      float xv[2][4][4];
#pragma unroll
      for (int m2 = 0; m2 < 2; ++m2)
#pragma unroll
        for (int jj = 0; jj < 4; ++jj) { const size_t ro = (size_t)(wr * 64 + (mh * 2 + m2) * 16 + q4 * 4 + jj) * DM;
          xv[m2][0][jj] = xo[ro]; xv[m2][1][jj] = xo[ro + 16]; xv[m2][2][jj] = xo[ro + 32]; xv[m2][3][jj] = xo[ro + 48]; }
#pragma unroll
      for (int m2 = 0; m2 < 2; ++m2)
#pragma unroll
        for (int jj = 0; jj < 4; ++jj) { const int mt = mh * 2 + m2; const size_t ro = (size_t)(wr * 64 + mt * 16 + q4 * 4 + jj) * DM;
          xo[ro] = xv[m2][0][jj] + g0 * acc[mt][0][jj]; xo[ro + 16] = xv[m2][1][jj] + g1 * acc[mt][1][jj];
          xo[ro + 32] = xv[m2][2][jj] + g2 * acc[mt][2][jj]; xo[ro + 48] = xv[m2][3][jj] + g3 * acc[mt][3][jj]; }
    }
    return;
  }
  float* ldsC = (float*)lds;
#pragma unroll
  for (int mt = 0; mt < 4; ++mt)
#pragma unroll
    for (int nt = 0; nt < 4; ++nt)
#pragma unroll
      for (int jj = 0; jj < 4; ++jj)
        ldsC[(wr * 64 + mt * 16 + q4 * 4 + jj) * 132 + wc * 64 + nt * 16 + c16] = acc[mt][nt][jj];
  __syncthreads();
  const int lr = tid >> 1, half = tid & 1;
  const int tok = row_base + lr;
  const float* cr = ldsC + lr * 132 + half * 64;
  if (EPI == EPI_FFNIN) {
    const int jc = tid & 7, rg = tid >> 3;
    const int ca = (jc >> 2) * 64 + (jc & 3) * 8;
    const int f0 = tile_n * 64 + jc * 8;
    const float* cw = p.in[30] + layer * 3 * FF + f0; const float* cbp = p.in[31] + layer * FF + f0;
    float w0[8], w1[8], w2[8], cb[8];
#pragma unroll
    for (int u = 0; u < 8; ++u) { w0[u] = cw[u]; w1[u] = cw[FF + u]; w2[u] = cw[2 * FF + u]; cb[u] = cbp[u]; }
    const int lr0 = rg * 4;
    float ap[8], ac[8], an[8];
    {
      const float* c0 = ldsC + (lr0 > 0 ? lr0 - 1 : 0) * 132 + ca;
      const float* c1 = ldsC + lr0 * 132 + ca;
#pragma unroll
      for (int u = 0; u < 8; ++u) { ap[u] = c0[u]; ac[u] = c1[u]; }
    }
    u32x4 outw[4];
    bool outv[4];
#pragma unroll
    for (int q = 0; q < 4; ++q) {
      const int lrq = lr0 + q, tk = row_base + lrq;
      const float* cn = ldsC + (lrq < 127 ? lrq + 1 : 127) * 132 + ca;
      const float* cbv = ldsC + lrq * 132 + ca + 32;
#pragma unroll
      for (int u = 0; u < 8; ++u) an[u] = cn[u];
      const int seqlen = tk < NLAT ? SEQL : CTXL;
      const int pos = tk < NLAT ? (tk & (SEQL - 1)) : ((tk - NLAT) & (CTXL - 1));
      const bool hp = pos > 0, hn = pos < seqlen - 1;
      float m[8];
#pragma unroll
      for (int u = 0; u < 8; ++u) {
        const float conv = cb[u] + (hp ? ap[u] * w0[u] : 0.f) + ac[u] * w1[u] + (hn ? an[u] * w2[u] : 0.f);
        m[u] = conv * sigmoidf_(conv) * cbv[u];
      }
      outw[q] = (u32x4){cvtpk(m[0], m[1]), cvtpk(m[2], m[3]), cvtpk(m[4], m[5]), cvtpk(m[6], m[7])};
      outv[q] = lrq >= 1 && lrq <= 126 && tk >= row_lo && tk < row_hi;
#pragma unroll
      for (int u = 0; u < 8; ++u) { ap[u] = ac[u]; ac[u] = an[u]; }
    }
    bf16_t* dst = (bf16_t*)(p.ws + OFF_X) + f0;
#pragma unroll
    for (int q = 0; q < 4; ++q) if (outv[q]) *(u32x4*)(dst + (size_t)(row_base + lr0 + q) * FF) = outw[q];
  }
  if (EPI == EPI_G1) {
    if (tile_n < 8) {
      float v[64]; float ss = 0;
#pragma unroll
      for (int c = 0; c < 64; ++c) { v[c] = cr[c]; ss += v[c] * v[c]; }
      ss += __shfl_xor(ss, 1);
      store64bf((bf16_t*)(p.ws + OFF_Y) + (size_t)tok * 1152 + tile_n * 128 + half * 64, v);
      if (half == 0) ((float*)(p.ws + OFF_SSQ))[(size_t)tok * 8 + tile_n] = ss;
    } else if (half == 0) {
      float v[64]; float ss = 0;
#pragma unroll
      for (int c = 0; c < 64; ++c) { v[c] = cr[c]; ss += v[c] * v[c]; }
      const float rs = rsqrtf(ss * (1.f / 64.f) + EPSN);
      const float* gk = p.in[27];
#pragma unroll
      for (int c = 0; c < 64; ++c) v[c] = v[c] * rs * gk[c];
      int b, pos;
      if (tok < NLAT) { b = tok >> 13; const int t = tok & (SEQL - 1); pos = CTXL + t; rope64(v, (const float*)(p.ws + OFF_ROPE), t); }
      else { b = (tok - NLAT) >> 8; pos = (tok - NLAT) & (CTXL - 1); }
      bf16_t* kb = (bf16_t*)(p.ws + OFF_K) + ((size_t)(b * 8) * KVL + pos) * 192 + 128;
#pragma unroll
      for (int c = 0; c < 64; c += 8) {
        u32x4 w = {cvtpk(v[c], v[c + 1]), cvtpk(v[c + 2], v[c + 3]), cvtpk(v[c + 4], v[c + 5]), cvtpk(v[c + 6], v[c + 7])};
#pragma unroll
        for (int h = 0; h < 8; ++h) *(u32x4*)(kb + (size_t)h * KVL * 192 + c) = w;
      }
    }
  }
  if (EPI == EPI_Q) {
    const float* sq = (const float*)(p.ws + OFF_SSQ) + (size_t)tok * 8;
    const float rq = rsqrtf((sq[0] + sq[1] + sq[2] + sq[3] + sq[4] + sq[5]) * (1.f / 768.f) + EPSN);
    const int b = tok >> 13, t = tok & (SEQL - 1);
    float v[64]; float ss = 0;
#pragma unroll
    for (int c = 0; c < 64; ++c) { v[c] = cr[c] * rq; ss += v[c] * v[c]; }
    bf16_t* qb = (bf16_t*)(p.ws + OFF_X);
    if (tile_n < 8) {
      ss += __shfl_xor(ss, 1);
      const float rs = rsqrtf(ss * (1.f / 128.f) + EPSN) * QSCALE;
      const float* gq = p.in[24] + half * 64;
#pragma unroll
      for (int c = 0; c < 64; ++c) v[c] = v[c] * rs * gq[c];
      store64bf(qb + ((size_t)(b * 8 + tile_n) * SEQL + t) * 192 + half * 64, v);
    } else {
      const int head = (tile_n - 8) * 2 + half;
      const float rs = rsqrtf(ss * (1.f / 64.f) + EPSN) * QSCALE;
      const float* gq = p.in[25];
#pragma unroll
      for (int c = 0; c < 64; ++c) v[c] = v[c] * rs * gq[c];
      rope64(v, (const float*)(p.ws + OFF_ROPE), t);
      store64bf(qb + ((size_t)(b * 8 + head) * SEQL + t) * 192 + 128, v);
    }
  }
  if (EPI == EPI_KV) {
    const float* sq = (const float*)(p.ws + OFF_SSQ) + (size_t)tok * 8;
    const float rkv = rsqrtf((sq[6] + sq[7]) * (1.f / 256.f) + EPSN);
    int b, pos;
    if (tok < NLAT) { b = tok >> 13; pos = CTXL + (tok & (SEQL - 1)); } else { b = (tok - NLAT) >> 8; pos = (tok - NLAT) & (CTXL - 1); }
    const int head = tile_n >> 1;
    float v[64]; float ss = 0;
#pragma unroll
    for (int c = 0; c < 64; ++c) { v[c] = cr[c] * rkv; ss += v[c] * v[c]; }
    if ((tile_n & 1) == 0) {
      ss += __shfl_xor(ss, 1);
      const float rs = rsqrtf(ss * (1.f / 128.f) + EPSN);
      const float* gk = p.in[26] + half * 64;
#pragma unroll
      for (int c = 0; c < 64; ++c) v[c] = v[c] * rs * gk[c];
      store64bf((bf16_t*)(p.ws + OFF_K) + ((size_t)(b * 8 + head) * KVL + pos) * 192 + half * 64, v);
    } else {
      store64bf((bf16_t*)(p.ws + OFF_ACTA) + ((size_t)(b * 8 + head) * KVL + pos) * 128 + half * 64, v);
    }
  }
  __syncthreads();
}

constexpr float ASCALE = 0.07216878364870322f;
constexpr float ATHR = 8.f;
constexpr int KROW = 400;
constexpr int K_LDS_BYTES = 64 * KROW;
constexpr int V_LDS_BYTES = 64 * 128 * 2;

DEVI void partialSM(f32x16& p0, f32x16& p1, float& m_reg, float& mn, float& alpha) {
  constexpr float L2E = 1.4426950408889634f;
  float pmax = p0[0];
#pragma unroll
  for (int r = 1; r < 16; ++r) pmax = fmaxf(pmax, p0[r]);
#pragma unroll
  for (int r = 0; r < 16; ++r) pmax = fmaxf(pmax, p1[r]);
  { auto rr = __builtin_amdgcn_permlane32_swap(__float_as_uint(pmax), __float_as_uint(pmax), false, false);
    pmax = fmaxf(__uint_as_float(rr[0]), __uint_as_float(rr[1])); }
  if (__builtin_expect(__all(pmax - m_reg <= ATHR * L2E), 1)) { mn = m_reg; alpha = 1.f; }
  else { mn = fmaxf(m_reg, pmax); alpha = __builtin_amdgcn_exp2f(m_reg - mn); m_reg = mn; }
#pragma unroll
  for (int r = 0; r < 16; ++r) p0[r] = __builtin_amdgcn_exp2f(p0[r] - mn);
#pragma unroll
  for (int r = 0; r < 16; ++r) p1[r] = __builtin_amdgcn_exp2f(p1[r] - mn);
}
DEVI void finishSM(f32x16& p0, f32x16& p1, float alpha, float& l_reg, bf16x8& pa0, bf16x8& pa1, bf16x8& pa2, bf16x8& pa3) {
  float s0 = p0[0] + p0[1], s1 = p0[2] + p0[3], s2 = p1[0] + p1[1], s3 = p1[2] + p1[3];
#pragma unroll
  for (int r = 4; r < 16; r += 4) { s0 += p0[r] + p0[r + 1]; s1 += p0[r + 2] + p0[r + 3]; s2 += p1[r] + p1[r + 1]; s3 += p1[r + 2] + p1[r + 3]; }
  l_reg = l_reg * alpha + ((s0 + s1) + (s2 + s3));
#define PK4(P, BASE, OUT) do { unsigned a0 = cvtpk(P[BASE + 0], P[BASE + 1]), a1 = cvtpk(P[BASE + 2], P[BASE + 3]);   \
    unsigned b0 = cvtpk(P[BASE + 4], P[BASE + 5]), b1 = cvtpk(P[BASE + 6], P[BASE + 7]);                              \
    auto r0 = __builtin_amdgcn_permlane32_swap(a0, b0, false, false); auto r1 = __builtin_amdgcn_permlane32_swap(a1, b1, false, false); \
    u32x4 w = {r0[0], r1[0], r0[1], r1[1]}; OUT = *reinterpret_cast<bf16x8*>(&w); } while (0)
  PK4(p0, 0, pa0); PK4(p0, 8, pa1); PK4(p1, 0, pa2); PK4(p1, 8, pa3);
#undef PK4
}
DEVI int v_st(int k) { const int kk = (k & ~0xC) | ((k & 4) << 1) | ((k & 8) >> 1); return ((kk >> 3) * 4) * 512 + ((kk & 7) * 32) * 2; }
DEVI int v_rd_base(int lane) { return ((lane & 3) << 3) | (((lane >> 2) & 3) << 6) | (((lane >> 4) & 1) << 5) | (((lane >> 5) & 1) << 8); }
constexpr int v_rd_off(int d0, int ks, int half) { return d0 * 512 + ks * 4096 + half * 2048; }
template <int OFF> DEVI s16x4 tr_read(int vb) {
  s16x4 r; asm volatile("ds_read_b64_tr_b16 %0, %1 offset:%2" : "=&v"(r) : "v"(vb), "i"(OFF) : "memory"); return r;
}
template <int D0> DEVI void pv_one(f32x16& od, int vb, bf16x8 pa0, bf16x8 pa1, bf16x8 pa2, bf16x8 pa3) {
  const s16x4 l0 = tr_read<v_rd_off(D0, 0, 0)>(vb), h0 = tr_read<v_rd_off(D0, 0, 1)>(vb), l1 = tr_read<v_rd_off(D0, 1, 0)>(vb), h1 = tr_read<v_rd_off(D0, 1, 1)>(vb);
  const s16x4 l2 = tr_read<v_rd_off(D0, 2, 0)>(vb), h2 = tr_read<v_rd_off(D0, 2, 1)>(vb), l3 = tr_read<v_rd_off(D0, 3, 0)>(vb), h3 = tr_read<v_rd_off(D0, 3, 1)>(vb);
  asm volatile("s_waitcnt lgkmcnt(0)" ::: "memory"); SBAR();
#define PK(L, H) (bf16x8){L[0], L[1], L[2], L[3], H[0], H[1], H[2], H[3]}
  od = __builtin_amdgcn_mfma_f32_32x32x16_bf16(pa0, PK(l0, h0), od, 0, 0, 0);
  od = __builtin_amdgcn_mfma_f32_32x32x16_bf16(pa1, PK(l1, h1), od, 0, 0, 0);
  od = __builtin_amdgcn_mfma_f32_32x32x16_bf16(pa2, PK(l2, h2), od, 0, 0, 0);
  od = __builtin_amdgcn_mfma_f32_32x32x16_bf16(pa3, PK(l3, h3), od, 0, 0, 0);
#undef PK
}

template <bool FIXED>
DEVI void attn_task(const bf16_t* __restrict__ Qb, const bf16_t* __restrict__ Kh, const bf16_t* __restrict__ Vh, bf16_t* __restrict__ Ob, char* lds, float shiftC) {
  const int tid = tid_(), wid = tid >> 6, lane = tid & 63, r32 = lane & 31, hi = lane >> 5;
  const int wu = __builtin_amdgcn_readfirstlane(wid);
  char* K_lds = lds; char* V_lds = lds + 24576;
  float* wsf = (float*)(lds + 24576 + 16384) + wid * 64; float* li_l = wsf; float* al_l = wsf + 32;
  float m_reg = -1e30f, l_reg = 0.f;
  f32x16 o[4] = {};
  bf16x8 qr[12];
  {
    const char* Qc = (const char*)Qb;
    const unsigned qoff = (unsigned)((wid * 32 + r32) * 192 + hi * 8) * 2u;
#pragma unroll
    for (int d0 = 0; d0 < 12; ++d0) qr[d0] = *(const bf16x8*)(Qc + (qoff + d0 * 32));
  }
  const char* Kc = (const char*)Kh; const char* Vc = (const char*)Vh;
  unsigned ksrc[6], vsrc[4];
#pragma unroll
  for (int e = 0; e < 6; ++e) {
    const unsigned byte = (unsigned)((wu * 6 + e) * 1024 + lane * 16);
    const unsigned r = byte / 384u, cpos = (byte - r * 384u) >> 4;
    ksrc[e] = r * 384u + (((cpos & ~7u) | ((cpos & 7u) ^ ((r >> 1) & 7u))) << 4);
  }
#pragma unroll
  for (int e = 0; e < 4; ++e) {
    const int st = 2 * (wu * 4 + e) + (lane >> 5);
    const int kk = (st >> 2) * 8 + ((lane & 31) >> 2), c = (st & 3) * 32 + (lane & 3) * 8;
    const int k = (kk & ~0xC) | ((kk & 4) << 1) | ((kk & 8) >> 1);
    vsrc[e] = (unsigned)(k * 256 + c * 2);
  }
#define KISSUE(k0) do { const char* kp_ = Kc + (size_t)(k0) * 384; _Pragma("unroll") for (int e = 0; e < 6; ++e) \
      __builtin_amdgcn_global_load_lds((const unsigned*)(kp_ + ksrc[e]), (unsigned*)(K_lds + (wu * 6 + e) * 1024), 16, 0, 0); } while (0)
#define VISSUE(k0) do { const char* vp_ = Vc + (size_t)(k0) * 256; _Pragma("unroll") for (int e = 0; e < 4; ++e) \
      __builtin_amdgcn_global_load_lds((const unsigned*)(vp_ + vsrc[e]), (unsigned*)(V_lds + (wu * 4 + e) * 1024), 16, 0, 0); } while (0)
#define ABAR() do { asm volatile("s_waitcnt vmcnt(0) lgkmcnt(0)" ::: "memory"); __builtin_amdgcn_s_barrier(); } while (0)
  const int vb0 = (int)(uintptr_t)V_lds + v_rd_base(lane);
  const int swz = (r32 >> 1) & 7;
  int kx[4];
#pragma unroll
  for (int i = 0; i < 4; ++i) kx[i] = ((2 * i + hi) ^ swz) << 4;
  const char* Kr0 = K_lds + r32 * 384;
  KISSUE(0); VISSUE(0); ABAR();
  constexpr int NT = KVL / 64;
  for (int j = 0; j < NT; ++j) {
    f32x16 p0 = {}, p1 = {};
#pragma unroll
    for (int d0 = 0; d0 < 12; ++d0) {
      const bf16x8 b0 = *(const bf16x8*)(Kr0 + (d0 >> 2) * 128 + kx[d0 & 3]);
      const bf16x8 b1 = *(const bf16x8*)(Kr0 + 32 * 384 + (d0 >> 2) * 128 + kx[d0 & 3]);
      p0 = __builtin_amdgcn_mfma_f32_32x32x16_bf16(b0, qr[d0], p0, 0, 0, 0);
      p1 = __builtin_amdgcn_mfma_f32_32x32x16_bf16(b1, qr[d0], p1, 0, 0, 0);
    }
    ABAR();
    if (j + 1 < NT) KISSUE((j + 1) * 64);
    float mn, alpha = 1.f;
    if constexpr (FIXED) {
#pragma unroll
      for (int r = 0; r < 16; ++r) p0[r] = __builtin_amdgcn_exp2f(p0[r]);
#pragma unroll
      for (int r = 0; r < 16; ++r) p1[r] = __builtin_amdgcn_exp2f(p1[r]);
    } else partialSM(p0, p1, m_reg, mn, alpha);
    if (!FIXED && __any(alpha < 1.f)) {
      if (hi == 0) al_l[r32] = alpha;
      asm volatile("s_waitcnt lgkmcnt(0)" ::: "memory");
#pragma unroll
      for (int r = 0; r < 16; ++r) { const float a = al_l[crow(r, hi)];
#pragma unroll
        for (int d = 0; d < 4; ++d) o[d][r] *= a; }
    }
    bf16x8 pa0, pa1, pa2, pa3;
    finishSM(p0, p1, alpha, l_reg, pa0, pa1, pa2, pa3);
    pv_one<0>(o[0], vb0, pa0, pa1, pa2, pa3); pv_one<1>(o[1], vb0, pa0, pa1, pa2, pa3);
    pv_one<2>(o[2], vb0, pa0, pa1, pa2, pa3); pv_one<3>(o[3], vb0, pa0, pa1, pa2, pa3);
    ABAR();
    if (j + 1 < NT) VISSUE((j + 1) * 64);
  }
#undef KISSUE
#undef VISSUE
#undef ABAR
  { auto rr = __builtin_amdgcn_permlane32_swap(__float_as_uint(l_reg), __float_as_uint(l_reg), false, false);
    l_reg = __uint_as_float(rr[0]) + __uint_as_float(rr[1]); }
  if (hi == 0) li_l[r32] = l_reg;
  asm volatile("s_waitcnt lgkmcnt(0)" ::: "memory");
  char* Oc = (char*)Ob;
#pragma unroll
  for (int r = 0; r < 16; ++r) {
    const int orow = crow(r, hi);
    const float rl = 1.f / li_l[orow];
    const unsigned ooff = (unsigned)((wid * 32 + orow) * LDP + r32) * 2u;
#pragma unroll
    for (int d0 = 0; d0 < 4; ++d0) *(bf16_t*)(Oc + (ooff + d0 * 64)) = f2bf(o[d0][r] * rl);
  }
  __syncthreads();
}

#define XB_TMO      128
#define XB_XCNT(j)  (256  + 64 * (j))
#define XB_XSUB(j)  (1280 + 64 * (j))
#define XB_XGEN(j)  (2304 + 64 * (j))
#define XB_TOP      3328
#define XB_TOPGEN   3392
#define XCD_BAR_WORDS 3456
#define XB_SPIN_CAP (1u << 24)
#define LAS __attribute__((address_space(3)))
DEVI unsigned xb_ld(unsigned* p)              { return __hip_atomic_load(p, __ATOMIC_RELAXED, __HIP_MEMORY_SCOPE_AGENT); }
DEVI unsigned xb_add(unsigned* p, unsigned v) { return __hip_atomic_fetch_add(p, v, __ATOMIC_RELAXED, __HIP_MEMORY_SCOPE_AGENT); }
DEVI unsigned xb_xcc_id() { return (unsigned)__builtin_amdgcn_s_getreg((3 << 11) | 20) & 0xFu; }
#define XB_SPIN(cond, bar) do { unsigned _sp = 0; while (cond) { __builtin_amdgcn_s_sleep(1); \
    if ((++_sp & 255u) == 0u) { if (xb_ld(&(bar)[XB_TMO])) break; if (_sp > XB_SPIN_CAP) { atomicAdd(&(bar)[XB_TMO], 1u); break; } } } } while (0)
struct XcdBarrier { unsigned* bar; unsigned x; volatile LAS unsigned* st; };
DEVI XcdBarrier xcd_barrier_post(unsigned* bar, volatile LAS unsigned* st) {
  XcdBarrier b; b.bar = bar; b.x = xb_xcc_id(); b.st = st;
  if (threadIdx.x == 0) (void)xb_add(&bar[XB_XCNT(b.x)], 1u);
  return b;
}
DEVI void xcd_barrier_complete(unsigned* bar, unsigned x, unsigned& nloc, unsigned& nx) {
  const unsigned G = gridDim.x * gridDim.y * gridDim.z;
  unsigned sum, cnt, mine, sp = 0u;
  for (;;) {
    sum = 0u; cnt = 0u; mine = 0u;
#pragma unroll
    for (unsigned j = 0; j < 16; ++j) { const unsigned c = xb_ld(&bar[XB_XCNT(j)]); sum += c; cnt += (c > 0u) ? 1u : 0u; mine = (j == x) ? c : mine; }
    if (sum == G) break;
    __builtin_amdgcn_s_sleep(1);
    if ((++sp & 255u) == 0u) { if (xb_ld(&bar[XB_TMO])) break; if (sp > XB_SPIN_CAP) { atomicAdd(&bar[XB_TMO], 1u); break; } }
  }
  nloc = mine > 0u ? mine : 1u; nx = cnt > 0u ? cnt : 1u;
}
DEVI void xcd_barrier(const XcdBarrier& b) {
  asm volatile("s_waitcnt vmcnt(0)" ::: "memory");
  __syncthreads();
  if (threadIdx.x == 0) {
    unsigned* bar = b.bar;
    __builtin_amdgcn_s_waitcnt(0);
    unsigned nloc = b.st[0], nx = b.st[1];
    if (nloc == 0u) { xcd_barrier_complete(bar, b.x, nloc, nx); b.st[0] = nloc; b.st[1] = nx; }
    const unsigned old = xb_add(&bar[XB_XSUB(b.x)], 1u);
    const unsigned gen = old / nloc;
    if (old + 1u == (gen + 1u) * nloc) {
      __builtin_amdgcn_fence(__ATOMIC_RELEASE, "agent");
      asm volatile("s_waitcnt vmcnt(0)" ::: "memory");
      const unsigned og = xb_add(&bar[XB_TOP], 1u);
      const unsigned tg = og / nx;
      if (og + 1u == (tg + 1u) * nx) xb_add(&bar[XB_TOPGEN], 1u);
      else XB_SPIN(xb_ld(&bar[XB_TOPGEN]) == tg, bar);
      __builtin_amdgcn_fence(__ATOMIC_ACQUIRE, "agent");
      xb_add(&bar[XB_XGEN(b.x)], 1u);
      asm volatile("s_waitcnt vmcnt(0)" ::: "memory");
    } else {
      XB_SPIN(xb_ld(&bar[XB_XGEN(b.x)]) == gen, bar);
      __builtin_amdgcn_fence(__ATOMIC_ACQUIRE, "agent");
      asm volatile("s_waitcnt vmcnt(0)" ::: "memory");
    }
  }
  __syncthreads();
}

#define GEMM_LOOP(MT, NT, SM, SN, ...) \
  { const int xcd_ = blockIdx.x & 7, nbs_ = gridDim.x >> 3; constexpr int SNT_ = ((NT) + (SN) - 1) / (SN), SMT_ = ((MT) + (SM) - 1) / (SM); \
    for (int w_ = blockIdx.x >> 3;; w_ += nbs_) { const int s_ = (w_ >> 6) * 8 + xcd_; if (s_ >= SMT_ * SNT_) break; const int slot_ = w_ & 63; \
      if (slot_ >= (SM) * (SN)) continue; \
      const int tm = (s_ / SNT_) * (SM) + slot_ / (SN), tn = (s_ % SNT_) * (SN) + slot_ % (SN); if (tm >= (MT) || tn >= (NT)) continue; __VA_ARGS__ } }

template <int PH>
DEVI void run_phase(const Params& p, char* lds) {
  unsigned char* ws = p.ws;
  const bf16_t* ACTA = (const bf16_t*)(ws + OFF_ACTA);
  const bf16_t* ACTB = (const bf16_t*)(ws + OFF_ACTB);
  float* ctxr = (float*)(ws + OFF_CTXR);
  if constexpr (PH == 0) phase_prep(p, lds);
  if constexpr (PH == 1) phase_norm(p, p.in[0], p.in[2], p.in[6], 0, 0, 1, NTOK);
  if constexpr (PH == 2) phase_s5_state(p);
  if constexpr (PH == 3) phase_s5_carry(p);
  if constexpr (PH == 4) phase_s5<true>(p, lds);
  if constexpr (PH == 5)
    GEMM_LOOP(264, 16, 8, 8, { gemm_tile<EPI_GLU, false>(p, ACTB, LDP, (const bf16_t*)(ws + OFF_WGLU), LDP, DM, tm * 128, 0, 0, tn, 0, 0, lds); })
  if constexpr (PH == 6) phase_norm(p, p.out, ctxr, p.in[7], 0, 3, 4, NTOK);
  if constexpr (PH == 7)
    GEMM_LOOP(270, 44, 16, 4, {
      const int rb = tm < 261 ? tm * 126 - 1 : NLAT + (tm - 261) * 126 - 1;
      const int lo = tm < 261 ? 0 : NLAT, hi = tm < 261 ? NLAT : NTOK;
      gemm_tile<EPI_FFNIN, true>(p, ACTA, LDP, (const bf16_t*)(ws + OFF_WFIN), LDP, DM, rb, lo, hi, tn, 0, 0, lds);
    })
  if constexpr (PH == 8)
    GEMM_LOOP(264, 8, 8, 8, { gemm_tile<EPI_RES, false>(p, (const bf16_t*)(ws + OFF_X), FF, (const bf16_t*)(ws + OFF_WFOUT), FF, FF, tm * 128, 0, 0, tn, 0, 5, lds); })
  if constexpr (PH == 9) phase_norm(p, p.out, ctxr, p.in[6] + DM, 1, 0, 1, NTOK);
  if constexpr (PH == 10)
    GEMM_LOOP(264, 9, 21, 3, { gemm_tile<EPI_G1, false>(p, ACTA, LDP, (const bf16_t*)(ws + OFF_WD), LDP, DM, tm * 128, 0, 0, tn, 1, 0, lds); })
  if constexpr (PH == 11)
    GEMM_LOOP(256, 12, 16, 4, { gemm_tile<EPI_Q, false>(p, (const bf16_t*)(ws + OFF_Y), 1152, (const bf16_t*)(ws + OFF_WUQ), 768, 768, tm * 128, 0, 0, tn, 1, 0, lds); })
  if constexpr (PH == 12)
    GEMM_LOOP(264, 16, 8, 8, { gemm_tile<EPI_KV, false>(p, (const bf16_t*)(ws + OFF_Y) + 768, 1152, (const bf16_t*)(ws + OFF_WUKV), 256, 256, tm * 128, 0, 0, tn, 1, 0, lds); })
  if constexpr (PH == 13) {
    float sbound;
    {
      const int ln = tid_() & 63;
      float mq = fmaxf(fabsf(p.in[24][ln]), fabsf(p.in[24][64 + ln])), mk = fmaxf(fabsf(p.in[26][ln]), fabsf(p.in[26][64 + ln]));
      float mqr = fabsf(p.in[25][ln]), mkr = fabsf(p.in[27][ln]);
#pragma unroll
      for (int o_ = 32; o_; o_ >>= 1) { mq = fmaxf(mq, __shfl_xor(mq, o_)); mk = fmaxf(mk, __shfl_xor(mk, o_)); mqr = fmaxf(mqr, __shfl_xor(mqr, o_)); mkr = fmaxf(mkr, __shfl_xor(mkr, o_)); }
      sbound = __int_as_float(__builtin_amdgcn_readfirstlane(__float_as_int(ASCALE * (128.f * mq * mk + 64.f * mqr * mkr) * 1.02f)));
    }
    for (int v = blockIdx.x; v < 2048; v += gridDim.x) {
      const int bh = (v >> 9) * 8 + (v & 7), qb = (v & 511) >> 3;
      const int b = bh >> 3, h = bh & 7;
      const bf16_t* Qp = (const bf16_t*)(ws + OFF_X) + ((size_t)bh * SEQL + qb * 128) * 192;
      const bf16_t* Kp = (const bf16_t*)(ws + OFF_K) + (size_t)bh * KVL * 192;
      const bf16_t* Vp = (const bf16_t*)(ws + OFF_ACTA) + (size_t)bh * KVL * 128;
      bf16_t* Op = (bf16_t*)(ws + OFF_ACTB) + ((size_t)(b * SEQL + qb * 128)) * LDP + h * 128;
      if (sbound <= 60.f) attn_task<true>(Qp, Kp, Vp, Op, lds, -sbound * 1.4426950408889634f);
      else attn_task<false>(Qp, Kp, Vp, Op, lds, 0.f);
    }
  }
  if constexpr (PH == 14)
    GEMM_LOOP(256, 8, 8, 8, { gemm_tile<EPI_RES, false>(p, ACTB, LDP, (const bf16_t*)(ws + OFF_WO), LDP, DM, tm * 128, 0, 0, tn, 1, 2, lds); })
  if constexpr (PH == 15) phase_norm(p, p.out, ctxr, p.in[7] + DM, 1, 3, 4, NLAT);
  if constexpr (PH == 16)
    GEMM_LOOP(261, 44, 16, 4, { gemm_tile<EPI_FFNIN, true>(p, ACTA, LDP, (const bf16_t*)(ws + OFF_WFIN + WFIN_BYTES), LDP, DM, tm * 126 - 1, 0, NLAT, tn, 1, 0, lds); })
  if constexpr (PH == 17)
    GEMM_LOOP(256, 8, 8, 8, { gemm_tile<EPI_RES, false>(p, (const bf16_t*)(ws + OFF_X), FF, (const bf16_t*)(ws + OFF_WFOUT + 5767168), FF, FF, tm * 128, 0, 0, tn, 1, 5, lds); })
}

#ifndef PHMASK
#define PHMASK 0x3ffff
#endif
#ifndef PROBE_MASK
#define PROBE_MASK 0
#endif
#define RUNP(N) do { if ((PHMASK >> N) & 1) { if ((PROBE_MASK >> N) & 1) { for (int r_ = 0; r_ < p.pad0; ++r_) { run_phase<N>(p, lds); SYNCG(); } } else run_phase<N>(p, lds); } } while (0)
#define SYNCG() xcd_barrier(xb)
__global__ void __launch_bounds__(256, 2) mega(Params p) {
  extern __shared__ __attribute__((aligned(16))) char lds[];
  volatile LAS unsigned* xst = (volatile LAS unsigned*)(lds + LDS_BYTES - 16);
  if (threadIdx.x == 0) { xst[0] = 0u; xst[1] = 0u; }
  __syncthreads();
  const XcdBarrier xb = xcd_barrier_post((unsigned*)(p.ws + OFF_BAR), xst);
  if (p.pad1) cg::this_grid().sync();
  RUNP(0); SYNCG(); RUNP(1); SYNCG(); RUNP(2); SYNCG(); RUNP(3); SYNCG(); RUNP(4); SYNCG(); RUNP(5); SYNCG();
  RUNP(6); SYNCG(); RUNP(7); SYNCG(); RUNP(8); SYNCG(); RUNP(9); SYNCG(); RUNP(10); SYNCG(); RUNP(11); RUNP(12); SYNCG();
  RUNP(13); SYNCG(); RUNP(14); SYNCG(); RUNP(15); SYNCG(); RUNP(16); SYNCG(); RUNP(17);
}
template <int PH>
__global__ void __launch_bounds__(256, 2) phase_kernel(Params p) {
  extern __shared__ __attribute__((aligned(16))) char lds[];
  run_phase<PH>(p, lds);
}


extern "C" void kernel_launch(void* const* d_in, const int* in_sizes, int n_in, void* d_out, int out_size, void* d_ws, size_t ws_size, hipStream_t stream) {
  static int grid_blocks = 0;
  if (grid_blocks == 0) {
    if (n_in != 33 || out_size != NLAT * DM || ws_size < WS_END) {
      fprintf(stderr, "kernel_launch: unexpected shapes n_in %d out %d ws %zu (need %zu)\n", n_in, out_size, ws_size, (size_t)WS_END);
      grid_blocks = -1; return;
    }
    int dev = 0, cus = 0, per_cu = 0;
    hipGetDevice(&dev);
    hipDeviceGetAttribute(&cus, hipDeviceAttributeMultiprocessorCount, dev);
    if (hipFuncSetAttribute((const void*)mega, hipFuncAttributeMaxDynamicSharedMemorySize, LDS_BYTES) != hipSuccess) {
      fprintf(stderr, "kernel_launch: hipFuncSetAttribute failed\n"); grid_blocks = -1; return; }
    hipOccupancyMaxActiveBlocksPerMultiprocessor(&per_cu, (const void*)mega, 256, LDS_BYTES);
    if (per_cu < 1) { fprintf(stderr, "kernel_launch: occupancy query returned %d\n", per_cu); per_cu = 1; }
    if (per_cu > 2) per_cu = 2;
    grid_blocks = cus * per_cu;
    (void)hipGetLastError();
  }
  if (grid_blocks < 0) return;
  Params p{};
  for (int i = 0; i < 33; ++i) p.in[i] = (const float*)d_in[i];
  p.out = (float*)d_out; p.ws = (unsigned char*)d_ws; p.pad0 = 2;
#if ONE_LAUNCH
  if (hipMemsetAsync((char*)d_ws + OFF_BAR, 0, XCD_BAR_WORDS * 4, stream) != hipSuccess) { fprintf(stderr, "memset failed\n"); return; }
  void* args[] = {&p};
  hipError_t e = hipLaunchCooperativeKernel((const void*)mega, dim3(grid_blocks), dim3(256), args, LDS_BYTES, stream);
  if (e != hipSuccess) fprintf(stderr, "cooperative launch failed: %s (grid %d)\n", hipGetErrorString(e), grid_blocks);
#else
#define LP(N) hipLaunchKernelGGL(phase_kernel<N>, dim3(grid_blocks), dim3(256), LDS_BYTES, stream, p)
  LP(0); LP(1); LP(2); LP(3); LP(4); LP(5); LP(6); LP(7); LP(8); LP(9); LP(10); LP(11); LP(12); LP(13); LP(14); LP(15); LP(16); LP(17);
#undef LP
#endif
}
```

```cpp
#include <hip/hip_runtime.h>
#include <hip/hip_cooperative_groups.h>
#include <cstdio>
#include <cstdint>
namespace cg = cooperative_groups;

#ifndef ONE_LAUNCH
#define ONE_LAUNCH 1
#endif

typedef unsigned short bf16_t;
using bf16x8 = __attribute__((ext_vector_type(8))) short;
using s16x4  = __attribute__((ext_vector_type(4))) short;
using f32x16 = __attribute__((ext_vector_type(16))) float;
using f32x4  = __attribute__((ext_vector_type(4))) float;
using u32x4  = __attribute__((ext_vector_type(4))) unsigned;
using u32x2  = __attribute__((ext_vector_type(2))) unsigned;

#define DEVI __device__ __forceinline__
#define SBAR() __builtin_amdgcn_sched_barrier(0)

constexpr int DM = 1024, NB = 4, SEQL = 8192, CTXL = 256;
constexpr int NLAT = NB * SEQL;
constexpr int NCTX = NB * CTXL;
constexpr int NTOK = NLAT + NCTX;
constexpr int FF = 2816;
constexpr int KVL = SEQL + CTXL;
constexpr int NCHUNK = 264;
constexpr float EPSN = 1e-6f;
constexpr int LDS_BYTES = 67584 + 16;
constexpr int LDP = 1088;

constexpr size_t OFF_MOD   = 0;
constexpr size_t OFF_S5AB  = OFF_MOD + 245760;
constexpr size_t OFF_ROPE  = OFF_S5AB + 131072;
constexpr size_t OFF_BBF   = OFF_ROPE + 16384;
constexpr size_t OFF_CMF   = OFF_BBF + 524288;
constexpr size_t OFF_WGLU  = OFF_CMF + 524288;
constexpr size_t OFF_WFIN  = OFF_WGLU + 4456448;
constexpr size_t WFIN_BYTES = 12255232;
constexpr size_t OFF_WFOUT = OFF_WFIN + 2 * WFIN_BYTES;
constexpr size_t OFF_WD    = OFF_WFOUT + 2 * 5767168;
constexpr size_t OFF_WUQ   = OFF_WD + 2506752;
constexpr size_t OFF_WUKV  = OFF_WUQ + 2359296;
constexpr size_t OFF_WO    = OFF_WUKV + 1048576;
constexpr size_t OFF_SSQ   = OFF_WO + 2228224;
constexpr size_t OFF_CTXR  = OFF_SSQ + 1081344;
constexpr size_t OFF_ACTA  = OFF_CTXR + 4194304;
constexpr size_t OFF_ACTB  = OFF_ACTA + 73531392;
constexpr size_t OFF_Y     = OFF_ACTB + 73531392;
constexpr size_t OFF_X     = OFF_Y + 77856768;
constexpr size_t OFF_K     = OFF_X + 100663296;
constexpr size_t OFF_BAR   = OFF_X + 204472320;
constexpr size_t WS_END    = OFF_BAR + 16384;

struct Params {
  const float* in[33];
  float* out;
  unsigned char* ws;
  int pad0, pad1;
};

DEVI unsigned cvtpk(float lo, float hi) { unsigned r; asm("v_cvt_pk_bf16_f32 %0, %1, %2" : "=v"(r) : "v"(lo), "v"(hi)); return r; }
DEVI bf16_t f2bf(float x) { return (bf16_t)(cvtpk(x, 0.f) & 0xffffu); }
DEVI float bf2f(bf16_t b) { return __uint_as_float(((unsigned)b) << 16); }
DEVI int tid_() { int t = threadIdx.x; asm volatile("" : "+v"(t)); return t; }
DEVI int crow(int r, int hi) { return (r & 3) + 8 * (r >> 2) + 4 * hi; }
DEVI float wave_sum(float v) {
#pragma unroll
  for (int o = 32; o; o >>= 1) v += __shfl_xor(v, o);
  return v;
}
DEVI float sigmoidf_(float x) { return 1.f / (1.f + __expf(-x)); }
DEVI float gelu_tanh(float x) {
  float u = 0.7978845608028654f * (x + 0.044715f * x * x * x);
  float t = 1.f - 2.f / (1.f + __expf(2.f * u));
  return 0.5f * x * (1.f + t);
}

DEVI int permrow(int perm, int n) {
  if (perm == 1) { int g = n >= 1024; int j = g ? n - 1024 : n; return (j >> 5) * 64 + g * 32 + (j & 31); }
  if (perm == 2) { int g = n >= FF; int j = g ? n - FF : n; return (j >> 5) * 64 + g * 32 + (j & 31); }
  if (perm == 3) { int h = n / 192, d = n - h * 192; return d < 128 ? h * 128 + d : 1024 + h * 64 + (d - 128); }
  return n;
}

DEVI void prep_transpose(int t, const float* src, int K, int N, bf16_t* dst, int ld, int perm, const float* scale, char* lds) {
  const int tid = tid_();
  float* tl = (float*)lds;
  const int ntn = N >> 6;
  const int tk = t / ntn, tn = t - tk * ntn;
  const int k0 = tk * 64, n0 = tn * 64;
#pragma unroll
  for (int e = 0; e < 16; ++e) {
    int idx = e * 256 + tid, i = idx >> 6, j = idx & 63;
    float v = src[(size_t)(k0 + i) * N + n0 + j];
    if (scale) v *= scale[k0 + i];
    tl[i * 65 + j] = v;
  }
  __syncthreads();
#pragma unroll
  for (int e = 0; e < 8; ++e) {
    int idx = e * 256 + tid, j = idx >> 5, ip = idx & 31;
    unsigned w = cvtpk(tl[(2 * ip) * 65 + j], tl[(2 * ip + 1) * 65 + j]);
    int nr = permrow(perm, n0 + j);
    *(unsigned*)(dst + (size_t)nr * ld + k0 + 2 * ip) = w;
  }
  __syncthreads();
}

constexpr int T_ADA = 384, T_TR = 5680, T_S5 = 32;
constexpr int T_TOTAL = T_ADA + T_TR + T_S5 + 2;

DEVI void phase_prep(const Params& p, char* lds) {
  const int tid = tid_();
  unsigned char* ws = p.ws;
  for (int idx = blockIdx.x; idx < T_TOTAL; idx += gridDim.x) {
    if (idx < T_ADA) {
      float* sl = (float*)lds;
      float* red = sl + 5 * 1024;
      for (int e = tid; e < 5 * 1024; e += 256) {
        int r = e >> 10, k = e & 1023;
        float c = r < 4 ? p.in[1][r * 1024 + k] : p.in[3][k];
        sl[e] = c * sigmoidf_(c);
      }
      __syncthreads();
      const int layer = idx / 192, cg_ = idx - layer * 192;
      const int cl = tid & 31, ks = tid >> 5;
      const int col = cg_ * 32 + cl;
      const float* w = p.in[4] + (size_t)layer * 1024 * 6144 + col;
      float a0 = 0, a1 = 0, a2 = 0, a3 = 0, a4 = 0;
#pragma unroll 8
      for (int k = ks * 128; k < ks * 128 + 128; ++k) {
        float wv = w[(size_t)k * 6144];
        a0 += sl[k] * wv; a1 += sl[1024 + k] * wv; a2 += sl[2048 + k] * wv; a3 += sl[3072 + k] * wv; a4 += sl[4096 + k] * wv;
      }
      red[(ks * 5 + 0) * 32 + cl] = a0; red[(ks * 5 + 1) * 32 + cl] = a1; red[(ks * 5 + 2) * 32 + cl] = a2;
      red[(ks * 5 + 3) * 32 + cl] = a3; red[(ks * 5 + 4) * 32 + cl] = a4;
      __syncthreads();
      if (tid < 160) {
        int r = tid >> 5, c2 = tid & 31;
        float s = 0;
#pragma unroll
        for (int q = 0; q < 8; ++q) s += red[(q * 5 + r) * 32 + c2];
        int cc = cg_ * 32 + c2;
        ((float*)(ws + OFF_MOD))[(layer * 5 + r) * 6144 + cc] = s + p.in[5][layer * 6144 + cc];
      }
      __syncthreads();
    } else if (idx < T_ADA + T_TR) {
      int t = idx - T_ADA;
      const float* tsrc; int tK, tN, tperm; bf16_t* tdst; const float* tscale = nullptr;
      if (t < 512) { tsrc = p.in[16]; tK = 1024; tN = 2048; tdst = (bf16_t*)(ws + OFF_WGLU); tperm = 1; }
      else if ((t -= 512) < 1408) { tsrc = p.in[29]; tK = 1024; tN = 5632; tdst = (bf16_t*)(ws + OFF_WFIN); tperm = 2; }
      else if ((t -= 1408) < 1408) { tsrc = p.in[29] + (size_t)1024 * 5632; tK = 1024; tN = 5632; tdst = (bf16_t*)(ws + OFF_WFIN + WFIN_BYTES); tperm = 2; }
      else if ((t -= 1408) < 704) { tsrc = p.in[32]; tK = 2816; tN = 1024; tdst = (bf16_t*)(ws + OFF_WFOUT); tperm = 0; }
      else if ((t -= 704) < 704) { tsrc = p.in[32] + (size_t)2816 * 1024; tK = 2816; tN = 1024; tdst = (bf16_t*)(ws + OFF_WFOUT + 5767168); tperm = 0; }
      else if ((t -= 704) < 192) { tsrc = p.in[18]; tK = 1024; tN = 768; tdst = (bf16_t*)(ws + OFF_WD); tperm = 0; }
      else if ((t -= 192) < 80) { tsrc = p.in[21]; tK = 1024; tN = 320; tdst = (bf16_t*)(ws + OFF_WD) + (size_t)768 * LDP; tperm = 0; }
      else if ((t -= 80) < 288) { tsrc = p.in[20]; tK = 768; tN = 1536; tdst = (bf16_t*)(ws + OFF_WUQ); tperm = 3; tscale = p.in[19]; }
      else if ((t -= 288) < 128) { tsrc = p.in[23]; tK = 256; tN = 2048; tdst = (bf16_t*)(ws + OFF_WUKV); tperm = 0; tscale = p.in[22]; }
      else { t -= 128; tsrc = p.in[28]; tK = 1024; tN = 1024; tdst = (bf16_t*)(ws + OFF_WO); tperm = 0; }
      prep_transpose(t, tsrc, tK, tN, tdst, tK == 1024 ? LDP : tK, tperm, tscale, lds);
    } else if (idx < T_ADA + T_TR + T_S5) {
      const int gid = (idx - T_ADA - T_TR) * 256 + tid;
      const int pp = gid & 63, dg = gid >> 6;
      const double dt = exp((double)p.in[10][dg]);
      const double lre = p.in[8][gid], lim = p.in[9][gid];
      const double mag = exp(lre * dt), ang = lim * dt;
      const double are = mag * cos(ang), aim = mag * sin(ang);
      const double den = lre * lre + lim * lim;
      const double zr = are - 1.0, zi = aim;
      const double fr = (zr * lre + zi * lim) / den, fi = (zi * lre - zr * lim) / den;
      double tr = are, ti = aim;
#pragma unroll
      for (int q = 0; q < 5; ++q) { double nr = tr * tr - ti * ti, ni = 2.0 * tr * ti; tr = nr; ti = ni; }
      float* tab = (float*)(ws + OFF_S5AB);
      tab[gid] = (float)are; tab[8192 + gid] = (float)aim; tab[16384 + gid] = (float)tr; tab[24576 + gid] = (float)ti;
      bf16_t* bbf = (bf16_t*)(ws + OFF_BBF);
      bf16_t* cmf = (bf16_t*)(ws + OFF_CMF);
      for (int c = 0; c < 16; ++c) {
        const double bre = p.in[11][(size_t)gid * 16 + c], bim = p.in[12][(size_t)gid * 16 + c];
        const float bbr = (float)(fr * bre - fi * bim), bbi = (float)(fr * bim + fi * bre);
        const int h = c >> 3, jj = c & 7, lane = h * 32 + (pp & 31);
        bbf[((size_t)(dg * 4 + (pp >> 5)) * 64 + lane) * 8 + jj] = f2bf(bbr);
        bbf[((size_t)(dg * 4 + 2 + (pp >> 5)) * 64 + lane) * 8 + jj] = f2bf(bbi);
        const float cre = p.in[13][((size_t)dg * 16 + c) * 64 + pp], cim = p.in[14][((size_t)dg * 16 + c) * 64 + pp];
        const int ks = pp >> 5, q = (pp & 31) >> 3, j2 = pp & 7, lane2 = q * 16 + c;
        cmf[((size_t)(dg * 4 + ks) * 64 + lane2) * 8 + j2] = f2bf(cre);
        cmf[((size_t)(dg * 4 + 2 + ks) * 64 + lane2) * 8 + j2] = f2bf(-cim);
      }
    } else if (idx == T_ADA + T_TR + T_S5) {
      float* rt = (float*)(ws + OFF_ROPE);
      for (int e = tid; e < 2048; e += 256) {
        int pos = e >> 4, i = e & 15;
        float inv = (float)pow(10000.0, -(double)i / 16.0);
        float ang = (float)pos * inv;
        rt[e * 2] = (float)cos((double)ang); rt[e * 2 + 1] = (float)sin((double)ang);
      }
    } else {
      u32x4 z = {0, 0, 0, 0};
      u32x4* d = (u32x4*)((bf16_t*)(ws + OFF_WD) + (size_t)1088 * LDP);
      for (int e = tid; e < 64 * LDP / 8; e += 256) d[e] = z;
    }
  }
}

DEVI void phase_norm(const Params& p, const float* src_lat, const float* src_ctx, const float* gn, int layer, int sh_idx, int sc_idx, int nrows) {
  const int lane = tid_() & 63, wid = tid_() >> 6;
  const float* mod = (const float*)(p.ws + OFF_MOD);
  bf16_t* dst = (bf16_t*)(p.ws + OFF_ACTA);
  for (int row = blockIdx.x * 4 + wid; row < nrows; row += gridDim.x * 4) {
    const float* s; int mr;
    if (row < NLAT) { s = src_lat + (size_t)row * DM; mr = row >> 13; } else { s = src_ctx + (size_t)(row - NLAT) * DM; mr = 4; }
    f32x4 v[4]; float ss = 0;
#pragma unroll
    for (int i = 0; i < 4; ++i) { v[i] = *(const f32x4*)(s + i * 256 + lane * 4); ss += v[i][0] * v[i][0] + v[i][1] * v[i][1] + v[i][2] * v[i][2] + v[i][3] * v[i][3]; }
    ss = wave_sum(ss);
    const float rs = rsqrtf(ss * (1.f / DM) + EPSN);
    const float* shp = mod + (layer * 5 + mr) * 6144 + sh_idx * 1024;
    const float* scp = mod + (layer * 5 + mr) * 6144 + sc_idx * 1024;
    f32x4 gg[4], shh[4], scc[4];
#pragma unroll
    for (int i = 0; i < 4; ++i) { const int c = i * 256 + lane * 4; gg[i] = *(const f32x4*)(gn + c); shh[i] = *(const f32x4*)(shp + c); scc[i] = *(const f32x4*)(scp + c); }
#pragma unroll
    for (int i = 0; i < 4; ++i) {
      const int c = i * 256 + lane * 4;
      float o0 = (v[i][0] * rs * gg[i][0]) * (1.f + scc[i][0]) + shh[i][0];
      float o1 = (v[i][1] * rs * gg[i][1]) * (1.f + scc[i][1]) + shh[i][1];
      float o2 = (v[i][2] * rs * gg[i][2]) * (1.f + scc[i][2]) + shh[i][2];
      float o3 = (v[i][3] * rs * gg[i][3]) * (1.f + scc[i][3]) + shh[i][3];
      u32x2 w = {cvtpk(o0, o1), cvtpk(o2, o3)};
      *(u32x2*)(dst + (size_t)row * LDP + c) = w;
    }
  }
}

template <bool PHASE_C>
DEVI void phase_s5(const Params& p, char* lds) {
  const int lane = tid_() & 63, wid = tid_() >> 6, r32 = lane & 31, hi = lane >> 5;
  float* wl = (float*)(lds + wid * 16896);
  const bf16_t* U = (const bf16_t*)(p.ws + OFF_ACTA);
  bf16_t* Z = (bf16_t*)(p.ws + OFF_ACTB);
  const float* tab = (const float*)(p.ws + OFF_S5AB);
  const bf16x8* bbf = (const bf16x8*)(p.ws + OFF_BBF);
  const bf16x8* cmf = (const bf16x8*)(p.ws + OFF_CMF);
  float* S = (float*)(p.ws + OFF_Y);
  for (int pc = blockIdx.x * 4 + wid; pc < NB * 64 * 8; pc += gridDim.x * 4) {
    const int pair = pc >> 3, sub = pc & 7, b = pair >> 6, g = pair & 63;
    bf16x8 bb[2][4], cm[2][4];
    float arr[2], aii[2];
#pragma unroll
    for (int d = 0; d < 2; ++d) {
      const int dg = d * 64 + g;
#pragma unroll
      for (int nt = 0; nt < 4; ++nt) bb[d][nt] = bbf[(size_t)(dg * 4 + nt) * 64 + lane];
      if (PHASE_C) {
#pragma unroll
        for (int ks = 0; ks < 4; ++ks) cm[d][ks] = cmf[(size_t)(dg * 4 + ks) * 64 + lane];
      }
      arr[d] = tab[dg * 64 + lane]; aii[d] = tab[8192 + dg * 64 + lane];
    }
    const float dsk = PHASE_C ? p.in[15][g * 16 + (lane & 15)] : 0.f;
   for (int kc = sub; kc < NCHUNK; kc += 8) {
    const int tok0 = kc < 256 ? b * SEQL + kc * 32 : NLAT + b * CTXL + (kc - 256) * 32;
    const bf16x8 afrag = *(const bf16x8*)(U + (size_t)(tok0 + r32) * LDP + g * 16 + hi * 8);
    f32x4 y0 = {0, 0, 0, 0}, y1 = {0, 0, 0, 0};
#pragma unroll
    for (int d = 0; d < 2; ++d) {
      const int j = kc < 256 ? (d ? 8 + 255 - kc : 8 + kc) : (d ? 7 - (kc - 256) : (kc - 256));
#pragma unroll
      for (int nt = 0; nt < 4; ++nt) {
        f32x16 acc = {};
        acc = __builtin_amdgcn_mfma_f32_32x32x16_bf16(afrag, bb[d][nt], acc, 0, 0, 0);
#pragma unroll
        for (int i = 0; i < 16; ++i) wl[crow(i, hi) * 132 + nt * 32 + r32] = acc[i];
      }
      asm volatile("s_waitcnt lgkmcnt(0)" ::: "memory");
      const float ar = arr[d], ai = aii[d];
      float hr = 0.f, him = 0.f;
      float* sp = S + ((size_t)((b * 2 + d) * 64 + g) * NCHUNK + j) * 128;
      if (PHASE_C) { hr = sp[lane]; him = sp[64 + lane]; }
      float bur[32], bui[32];
#pragma unroll
      for (int s = 0; s < 32; ++s) { bur[s] = wl[s * 132 + lane]; bui[s] = wl[s * 132 + 64 + lane]; }
#pragma unroll
      for (int s = 0; s < 32; ++s) {
        const int t = d ? 31 - s : s;
        const float nr = ar * hr - ai * him + bur[t];
        const float ni = ar * him + ai * hr + bui[t];
        hr = nr; him = ni;
        if (PHASE_C) { bur[t] = hr; bui[t] = him; }
      }
      if (PHASE_C) {
#pragma unroll
        for (int s = 0; s < 32; ++s) { wl[s * 132 + lane] = bur[s]; wl[s * 132 + 64 + lane] = bui[s]; }
      }
      if (!PHASE_C) { sp[lane] = hr; sp[64 + lane] = him; }
      if (PHASE_C) {
        asm volatile("s_waitcnt lgkmcnt(0)" ::: "memory");
#pragma unroll
        for (int ks = 0; ks < 4; ++ks) {
          const bf16x8 cf = cm[d][ks];
          const float* a0p = wl + (lane & 15) * 132 + ks * 32 + (lane >> 4) * 8;
          const f32x4 a00 = *(const f32x4*)a0p, a01 = *(const f32x4*)(a0p + 4);
          const f32x4 a10 = *(const f32x4*)(a0p + 16 * 132), a11 = *(const f32x4*)(a0p + 16 * 132 + 4);
          u32x4 w0 = {cvtpk(a00[0], a00[1]), cvtpk(a00[2], a00[3]), cvtpk(a01[0], a01[1]), cvtpk(a01[2], a01[3])};
          u32x4 w1 = {cvtpk(a10[0], a10[1]), cvtpk(a10[2], a10[3]), cvtpk(a11[0], a11[1]), cvtpk(a11[2], a11[3])};
          y0 = __builtin_amdgcn_mfma_f32_16x16x32_bf16(*(bf16x8*)&w0, cf, y0, 0, 0, 0);
          y1 = __builtin_amdgcn_mfma_f32_16x16x32_bf16(*(bf16x8*)&w1, cf, y1, 0, 0, 0);
        }
        asm volatile("s_waitcnt lgkmcnt(0)" ::: "memory");
      }
    }
    if (PHASE_C) {
      const int c = lane & 15, ch = g * 16 + c;
      float u0[4], u1[4];
#pragma unroll
      for (int r = 0; r < 4; ++r) {
        const int t0 = (lane >> 4) * 4 + r;
        u0[r] = bf2f(U[(size_t)(tok0 + t0) * LDP + ch]); u1[r] = bf2f(U[(size_t)(tok0 + 16 + t0) * LDP + ch]);
      }
#pragma unroll
      for (int r = 0; r < 4; ++r) {
        const int t0 = (lane >> 4) * 4 + r;
        Z[(size_t)(tok0 + t0) * LDP + ch] = f2bf(gelu_tanh(y0[r] + dsk * u0[r]));
        Z[(size_t)(tok0 + 16 + t0) * LDP + ch] = f2bf(gelu_tanh(y1[r] + dsk * u1[r]));
      }
    }
   }
  }
}

DEVI void phase_s5_state(const Params& p) {
  const int lane = tid_() & 63, wid = tid_() >> 6, r32 = lane & 31, hi = lane >> 5;
  const bf16_t* U = (const bf16_t*)(p.ws + OFF_ACTA);
  const float* tab = (const float*)(p.ws + OFF_S5AB);
  const bf16x8* bbf = (const bf16x8*)(p.ws + OFF_BBF);
  float* S = (float*)(p.ws + OFF_Y);
  for (int pc = blockIdx.x * 4 + wid; pc < NB * 64 * 8; pc += gridDim.x * 4) {
    const int pair = pc >> 3, sub = pc & 7, b = pair >> 6, g = pair & 63;
    bf16x8 bb[2][4];
    float lr_[2][2], li_[2][2], pr_[2][2], pi_[2][2], qr_[2][2], qi_[2][2];
#pragma unroll
    for (int d = 0; d < 2; ++d) {
      const int dg = d * 64 + g;
#pragma unroll
      for (int nt = 0; nt < 4; ++nt) bb[d][nt] = bbf[(size_t)(dg * 4 + nt) * 64 + lane];
#pragma unroll
      for (int st = 0; st < 2; ++st) {
        const float ar = tab[dg * 64 + st * 32 + r32], ai = tab[8192 + dg * 64 + st * 32 + r32];
        const float a2r = ar * ar - ai * ai, a2i = 2.f * ar * ai;
        const float a4r = a2r * a2r - a2i * a2i, a4i = 2.f * a2r * a2i;
        lr_[d][st] = ar; li_[d][st] = ai;
        const bool post = (hi == d);
        pr_[d][st] = post ? 1.f : a4r; pi_[d][st] = post ? 0.f : a4i;
        qr_[d][st] = post ? a4r : 1.f; qi_[d][st] = post ? a4i : 0.f;
      }
    }
    for (int kc = sub; kc < NCHUNK; kc += 8) {
      const int tok0 = kc < 256 ? b * SEQL + kc * 32 : NLAT + b * CTXL + (kc - 256) * 32;
      const bf16x8 afrag = *(const bf16x8*)(U + (size_t)(tok0 + r32) * LDP + g * 16 + hi * 8);
#pragma unroll
      for (int d = 0; d < 2; ++d) {
        const int j = kc < 256 ? (d ? 8 + 255 - kc : 8 + kc) : (d ? 7 - (kc - 256) : (kc - 256));
        float* sp = S + ((size_t)((b * 2 + d) * 64 + g) * NCHUNK + j) * 128;
#pragma unroll
        for (int st = 0; st < 2; ++st) {
          f32x16 acr = {}, aci = {};
          acr = __builtin_amdgcn_mfma_f32_32x32x16_bf16(afrag, bb[d][st], acr, 0, 0, 0);
          aci = __builtin_amdgcn_mfma_f32_32x32x16_bf16(afrag, bb[d][st + 2], aci, 0, 0, 0);
          const float ar = lr_[d][st], ai = li_[d][st];
          float hr = 0.f, him = 0.f;
#pragma unroll
          for (int g4 = 0; g4 < 4; ++g4) {
            const int G = d ? 3 - g4 : g4;
            { const float nr = pr_[d][st] * hr - pi_[d][st] * him, ni = pr_[d][st] * him + pi_[d][st] * hr; hr = nr; him = ni; }
#pragma unroll
            for (int jj = 0; jj < 4; ++jj) {
              const int i = G * 4 + (d ? 3 - jj : jj);
              const float nr = ar * hr - ai * him + acr[i];
              const float ni = ar * him + ai * hr + aci[i];
              hr = nr; him = ni;
            }
            { const float nr = qr_[d][st] * hr - qi_[d][st] * him, ni = qr_[d][st] * him + qi_[d][st] * hr; hr = nr; him = ni; }
          }
          { auto rr = __builtin_amdgcn_permlane32_swap(__float_as_uint(hr), __float_as_uint(hr), false, false);
            hr = __uint_as_float(rr[0]) + __uint_as_float(rr[1]); }
          { auto rr = __builtin_amdgcn_permlane32_swap(__float_as_uint(him), __float_as_uint(him), false, false);
            him = __uint_as_float(rr[0]) + __uint_as_float(rr[1]); }
          if (hi == st) { sp[st * 32 + r32] = hr; sp[64 + st * 32 + r32] = him; }
        }
      }
    }
  }
}

DEVI void phase_s5_carry(const Params& p) {
  const int lane = tid_() & 63, wid = tid_() >> 6;
  const float* tab = (const float*)(p.ws + OFF_S5AB);
  float* S = (float*)(p.ws + OFF_Y);
  for (int task = blockIdx.x * 4 + wid; task < NB * 2 * 64; task += gridDim.x * 4) {
    const int g = task & 63, d = (task >> 6) & 1;
    const float lr = tab[16384 + (d * 64 + g) * 64 + lane], li = tab[24576 + (d * 64 + g) * 64 + lane];
    float* sp = S + (size_t)task * NCHUNK * 128;
    float hr = 0.f, him = 0.f;
    float tr[8], ti[8], ur[8], ui[8];
#pragma unroll
    for (int q = 0; q < 8; ++q) { tr[q] = sp[q * 128 + lane]; ti[q] = sp[q * 128 + 64 + lane]; }
    for (int j0 = 0; j0 < NCHUNK; j0 += 8) {
      if (j0 + 8 < NCHUNK) {
#pragma unroll
        for (int q = 0; q < 8; ++q) { ur[q] = sp[(j0 + 8 + q) * 128 + lane]; ui[q] = sp[(j0 + 8 + q) * 128 + 64 + lane]; }
      }
#pragma unroll
      for (int q = 0; q < 8; ++q) {
        sp[(j0 + q) * 128 + lane] = hr; sp[(j0 + q) * 128 + 64 + lane] = him;
        const float nr = lr * hr - li * him + tr[q];
        const float ni = lr * him + li * hr + ti[q];
        hr = nr; him = ni;
      }
#pragma unroll
      for (int q = 0; q < 8; ++q) { tr[q] = ur[q]; ti[q] = ui[q]; }
    }
  }
}

constexpr float QSCALE = 0.07216878364870322f * 1.4426950408889634f;
enum { EPI_GLU = 0, EPI_RES = 1, EPI_FFNIN = 2, EPI_G1 = 3, EPI_Q = 4, EPI_KV = 5 };

DEVI void rope64(float* v, const float* rt, int t) {
  const float* rr = rt + (t >> 6) * 32;
  const float* rc = rt + (t & 63) * 32;
#pragma unroll
  for (int i = 0; i < 16; ++i) {
    float c = rr[i * 2], s = rr[i * 2 + 1], x1 = v[i], x2 = v[16 + i];
    v[i] = x1 * c - x2 * s; v[16 + i] = x1 * s + x2 * c;
    c = rc[i * 2]; s = rc[i * 2 + 1]; x1 = v[32 + i]; x2 = v[48 + i];
    v[32 + i] = x1 * c - x2 * s; v[48 + i] = x1 * s + x2 * c;
  }
}
DEVI void store64bf(bf16_t* dst, const float* v) {
#pragma unroll
  for (int c = 0; c < 64; c += 8) {
    u32x4 w = {cvtpk(v[c], v[c + 1]), cvtpk(v[c + 2], v[c + 3]), cvtpk(v[c + 4], v[c + 5]), cvtpk(v[c + 6], v[c + 7])};
    *(u32x4*)(dst + c) = w;
  }
}

template <int EPI, bool GUARD>
DEVI void gemm_tile(const Params& p, const bf16_t* __restrict__ A, int lda, const bf16_t* __restrict__ Bt, int ldb, int K,
                          int row_base, int row_lo, int row_hi, int tile_n, int layer, int which, char* lds) {
  const int tid = tid_(), lane = tid & 63, wid = tid >> 6, wr = wid >> 1, wc = wid & 1, c16 = lane & 15, q4 = lane >> 4;
  f32x4 acc[4][4] = {};
  const int wq = __builtin_amdgcn_readfirstlane(wid) * 4;
  const int lrow = lane >> 3, lcp = lane & 7;
  const char* Abase = (const char*)(A + (long)row_base * lda);
  const char* Bbase = (const char*)(Bt + (long)(tile_n * 128) * ldb);
  unsigned aoff[4], boff[4];
#pragma unroll
  for (int e = 0; e < 4; ++e) {
    const int r = (wq + e) * 8 + lrow;
    const int kc = lcp ^ ((r >> 1) & 7);
    int gr = row_base + r;
    if (GUARD) gr = gr < row_lo ? row_lo : (gr >= row_hi ? row_hi - 1 : gr);
    aoff[e] = (unsigned)(((gr - row_base) * lda + kc * 8) * 2);
    boff[e] = (unsigned)((r * ldb + kc * 8) * 2);
  }
#define GISSUE(k0, buf) do { const char* ak_ = Abase + (size_t)(k0) * 2; const char* bk_ = Bbase + (size_t)(k0) * 2; _Pragma("unroll") for (int e = 0; e < 4; ++e) { \
      __builtin_amdgcn_global_load_lds((const unsigned*)(ak_ + aoff[e]), (unsigned*)(lds + (buf) * 32768 + (wq + e) * 1024), 16, 0, 0); \
      __builtin_amdgcn_global_load_lds((const unsigned*)(bk_ + boff[e]), (unsigned*)(lds + (buf) * 32768 + 16384 + (wq + e) * 1024), 16, 0, 0); } } while (0)
  const int swz = c16 >> 1;
  int koff[2];
#pragma unroll
  for (int ks = 0; ks < 2; ++ks) koff[ks] = ((ks * 4 + q4) ^ swz) << 4;
  const int arow = (wr * 64 + c16) * 128, brow = 16384 + (wc * 64 + c16) * 128;
#define KSTEPS(buf) do { const char* Lb = lds + (buf) * 32768; _Pragma("unroll") for (int ks = 0; ks < 2; ++ks) { \
      bf16x8 af[4], bfr[4]; \
      _Pragma("unroll") for (int t = 0; t < 4; ++t) { af[t] = *(const bf16x8*)(Lb + arow + t * 2048 + koff[ks]); bfr[t] = *(const bf16x8*)(Lb + brow + t * 2048 + koff[ks]); } \
      _Pragma("unroll") for (int mt = 0; mt < 4; ++mt) _Pragma("unroll") for (int nt = 0; nt < 4; ++nt) \
        acc[mt][nt] = __builtin_amdgcn_mfma_f32_16x16x32_bf16(af[mt], bfr[nt], acc[mt][nt], 0, 0, 0); } } while (0)
#define GBAR() do { asm volatile("s_waitcnt vmcnt(0) lgkmcnt(0)" ::: "memory"); __builtin_amdgcn_s_barrier(); } while (0)
  GISSUE(0, 0); GBAR();
  for (int k0 = 0; k0 < K; k0 += 128) {
    GISSUE(k0 + 64, 1);
    KSTEPS(0);
    GBAR();
    if (k0 + 128 < K) GISSUE(k0 + 128, 0);
    KSTEPS(1);
    GBAR();
  }
#undef GISSUE
#undef KSTEPS
#undef GBAR
  const float* mod = (const float*)(p.ws + OFF_MOD);
  float* ctxr = (float*)(p.ws + OFF_CTXR);
  if (EPI == EPI_GLU) {
    const float* gb = p.in[17];
    const int j0 = tile_n * 64 + wc * 32 + c16;
    const bool lat = row_base < NLAT;
    const float* mg = mod + (lat ? (row_base >> 13) : 4) * 6144 + 2048;
    const float ba0 = gb[j0], ba1 = gb[j0 + 16], bg0 = gb[1024 + j0], bg1 = gb[1024 + j0 + 16], gt0 = mg[j0], gt1 = mg[j0 + 16];
    const float* xin = (lat ? p.in[0] + (size_t)row_base * DM : p.in[2] + (size_t)(row_base - NLAT) * DM) + j0;
    float* xo = (lat ? p.out + (size_t)row_base * DM : ctxr + (size_t)(row_base - NLAT) * DM) + j0;
#pragma unroll
    for (int mh = 0; mh < 2; ++mh) {
      float xv[2][2][4];
#pragma unroll
      for (int m2 = 0; m2 < 2; ++m2)
#pragma unroll
        for (int jj = 0; jj < 4; ++jj) { const size_t ro = (size_t)(wr * 64 + (mh * 2 + m2) * 16 + q4 * 4 + jj) * DM; xv[m2][0][jj] = xin[ro]; xv[m2][1][jj] = xin[ro + 16]; }
#pragma unroll
      for (int m2 = 0; m2 < 2; ++m2)
#pragma unroll
        for (int jj = 0; jj < 4; ++jj) {
          const int mt = mh * 2 + m2; const size_t ro = (size_t)(wr * 64 + mt * 16 + q4 * 4 + jj) * DM;
          xo[ro] = xv[m2][0][jj] + gt0 * ((acc[mt][0][jj] + ba0) * sigmoidf_(acc[mt][2][jj] + bg0));
          xo[ro + 16] = xv[m2][1][jj] + gt1 * ((acc[mt][1][jj] + ba1) * sigmoidf_(acc[mt][3][jj] + bg1));
        }
    }
    return;
  }
  if (EPI == EPI_RES) {
    const bool lat = row_base < NLAT;
    const float* gp = mod + (layer * 5 + (lat ? (row_base >> 13) : 4)) * 6144 + which * 1024 + tile_n * 128 + wc * 64 + c16;
    const float g0 = gp[0], g1 = gp[16], g2 = gp[32], g3 = gp[48];
    float* xo = (lat ? p.out + (size_t)row_base * DM : ctxr + (size_t)(row_base - NLAT) * DM) + tile_n * 128 + wc * 64 + c16;
#pragma unroll
    for (int mh = 0; mh < 2; ++mh) {
      float xv[2][4][4];
#pragma unroll
      for (int m2 = 0; m2 < 2; ++m2)
#pragma unroll
        for (int jj = 0; jj < 4; ++jj) { const size_t ro = (size_t)(wr * 64 + (mh * 2 + m2) * 16 + q4 * 4 + jj) * DM;
          xv[m2][0][jj] = xo[ro]; xv[m2][1][jj] = xo[ro + 16]; xv[m2][2][jj] = xo[ro + 32]; xv[m2][3][jj] = xo[ro + 48]; }
#pragma unroll
      for (int m2 = 0; m2 < 2; ++m2)
#pragma unroll
        for (int jj = 0; jj < 4; ++jj) { const int mt = mh * 2 + m2; const size_t ro = (size_t)(wr * 64 + mt * 16 + q4 * 4 + jj) * DM;
          xo[ro] = xv[m2][0][jj] + g0 * acc[mt][0][jj]; xo[ro + 16] = xv[m2][1][jj] + g1 * acc[mt][1][jj];
          xo[ro + 32] = xv[m2][2][jj] + g2 * acc[mt][2][jj]; xo[ro + 48] = xv[m2][3][jj] + g3 * acc[mt][3][jj]; }
    }
    return;
  }
  float* ldsC = (float*)lds;
#pragma unroll
  for (int mt = 0; mt < 4; ++mt)
#pragma unroll
    for (int nt = 0; nt < 4; ++nt)
#pragma unroll
      for (int jj = 0; jj < 4; ++jj)
        ldsC[(wr * 64 + mt * 16 + q4 * 4 + jj) * 132 + wc * 64 + nt * 16 + c16] = acc[mt][nt][jj];
  __syncthreads();
  const int lr = tid >> 1, half = tid & 1;
  const int tok = row_base + lr;
  const float* cr = ldsC + lr * 132 + half * 64;
  if (EPI == EPI_FFNIN) {
    const int jc = tid & 7, rg = tid >> 3;
    const int ca = (jc >> 2) * 64 + (jc & 3) * 8;
    const int f0 = tile_n * 64 + jc * 8;
    const float* cw = p.in[30] + layer * 3 * FF + f0; const float* cbp = p.in[31] + layer * FF + f0;
    float w0[8], w1[8], w2[8], cb[8];
#pragma unroll
    for (int u = 0; u < 8; ++u) { w0[u] = cw[u]; w1[u] = cw[FF + u]; w2[u] = cw[2 * FF + u]; cb[u] = cbp[u]; }
    const int lr0 = rg * 4;
    float ap[8], ac[8], an[8];
    {
      const float* c0 = ldsC + (lr0 > 0 ? lr0 - 1 : 0) * 132 + ca;
      const float* c1 = ldsC + lr0 * 132 + ca;
#pragma unroll
      for (int u = 0; u < 8; ++u) { ap[u] = c0[u]; ac[u] = c1[u]; }
    }
    u32x4 outw[4];
    bool outv[4];
#pragma unroll
    for (int q = 0; q < 4; ++q) {
      const int lrq = lr0 + q, tk = row_base + lrq;
      const float* cn = ldsC + (lrq < 127 ? lrq + 1 : 127) * 132 + ca;
      const float* cbv = ldsC + lrq * 132 + ca + 32;
#pragma unroll
      for (int u = 0; u < 8; ++u) an[u] = cn[u];
      const int seqlen = tk < NLAT ? SEQL : CTXL;
      const int pos = tk < NLAT ? (tk & (SEQL - 1)) : ((tk - NLAT) & (CTXL - 1));
      const bool hp = pos > 0, hn = pos < seqlen - 1;
      float m[8];
#pragma unroll
      for (int u = 0; u < 8; ++u) {
        const float conv = cb[u] + (hp ? ap[u] * w0[u] : 0.f) + ac[u] * w1[u] + (hn ? an[u] * w2[u] : 0.f);
        m[u] = conv * sigmoidf_(conv) * cbv[u];
      }
      outw[q] = (u32x4){cvtpk(m[0], m[1]), cvtpk(m[2], m[3]), cvtpk(m[4], m[5]), cvtpk(m[6], m[7])};
      outv[q] = lrq >= 1 && lrq <= 126 && tk >= row_lo && tk < row_hi;
#pragma unroll
      for (int u = 0; u < 8; ++u) { ap[u] = ac[u]; ac[u] = an[u]; }
    }
    bf16_t* dst = (bf16_t*)(p.ws + OFF_X) + f0;
#pragma unroll
    for (int q = 0; q < 4; ++q) if (outv[q]) *(u32x4*)(dst + (size_t)(row_base + lr0 + q) * FF) = outw[q];
  }
  if (EPI == EPI_G1) {
    if (tile_n < 8) {
      float v[64]; float ss = 0;
#pragma unroll
      for (int c = 0; c < 64; ++c) { v[c] = cr[c]; ss += v[c] * v[c]; }
      ss += __shfl_xor(ss, 1);
      store64bf((bf16_t*)(p.ws + OFF_Y) + (size_t)tok * 1152 + tile_n * 128 + half * 64, v);
      if (half == 0) ((float*)(p.ws + OFF_SSQ))[(size_t)tok * 8 + tile_n] = ss;
    } else if (half == 0) {
      float v[64]; float ss = 0;
#pragma unroll
      for (int c = 0; c < 64; ++c) { v[c] = cr[c]; ss += v[c] * v[c]; }
      const float rs = rsqrtf(ss * (1.f / 64.f) + EPSN);
      const float* gk = p.in[27];
#pragma unroll
      for (int c = 0; c < 64; ++c) v[c] = v[c] * rs * gk[c];
      int b, pos;
      if (tok < NLAT) { b = tok >> 13; const int t = tok & (SEQL - 1); pos = CTXL + t; rope64(v, (const float*)(p.ws + OFF_ROPE), t); }
      else { b = (tok - NLAT) >> 8; pos = (tok - NLAT) & (CTXL - 1); }
      bf16_t* kb = (bf16_t*)(p.ws + OFF_K) + ((size_t)(b * 8) * KVL + pos) * 192 + 128;
#pragma unroll
      for (int c = 0; c < 64; c += 8) {
        u32x4 w = {cvtpk(v[c], v[c + 1]), cvtpk(v[c + 2], v[c + 3]), cvtpk(v[c + 4], v[c + 5]), cvtpk(v[c + 6], v[c + 7])};
#pragma unroll
        for (int h = 0; h < 8; ++h) *(u32x4*)(kb + (size_t)h * KVL * 192 + c) = w;
      }
    }
  }
  if (EPI == EPI_Q) {
    const float* sq = (const float*)(p.ws + OFF_SSQ) + (size_t)tok * 8;
    const float rq = rsqrtf((sq[0] + sq[1] + sq[2] + sq[3] + sq[4] + sq[5]) * (1.f / 768.f) + EPSN);
    const int b = tok >> 13, t = tok & (SEQL - 1);
    float v[64]; float ss = 0;
#pragma unroll
    for (int c = 0; c < 64; ++c) { v[c] = cr[c] * rq; ss += v[c] * v[c]; }
    bf16_t* qb = (bf16_t*)(p.ws + OFF_X);
    if (tile_n < 8) {
      ss += __shfl_xor(ss, 1);
      const float rs = rsqrtf(ss * (1.f / 128.f) + EPSN) * QSCALE;
      const float* gq = p.in[24] + half * 64;
#pragma unroll
      for (int c = 0; c < 64; ++c) v[c] = v[c] * rs * gq[c];
      store64bf(qb + ((size_t)(b * 8 + tile_n) * SEQL + t) * 192 + half * 64, v);
    } else {
      const int head = (tile_n - 8) * 2 + half;
      const float rs = rsqrtf(ss * (1.f / 64.f) + EPSN) * QSCALE;
      const float* gq = p.in[25];
#pragma unroll
      for (int c = 0; c < 64; ++c) v[c] = v[c] * rs * gq[c];
      rope64(v, (const float*)(p.ws + OFF_ROPE), t);
      store64bf(qb + ((size_t)(b * 8 + head) * SEQL + t) * 192 + 128, v);
    }
  }
  if (EPI == EPI_KV) {
    const float* sq = (const float*)(p.ws + OFF_SSQ) + (size_t)tok * 8;
    const float rkv = rsqrtf((sq[6] + sq[7]) * (1.f / 256.f) + EPSN);
    int b, pos;
    if (tok < NLAT) { b = tok >> 13; pos = CTXL + (tok & (SEQL - 1)); } else { b = (tok - NLAT) >> 8; pos = (tok - NLAT) & (CTXL - 1); }
    const int head = tile_n >> 1;
    float v[64]; float ss = 0;
#pragma unroll
    for (int c = 0; c < 64; ++c) { v[c] = cr[c] * rkv; ss += v[c] * v[c]; }
    if ((tile_n & 1) == 0) {
      ss += __shfl_xor(ss, 1);
      const float rs = rsqrtf(ss * (1.f / 128.f) + EPSN);
      const float* gk = p.in[26] + half * 64;
#pragma unroll
      for (int c = 0; c < 64; ++c) v[c] = v[c] * rs * gk[c];
      store64bf((bf16_t*)(p.ws + OFF_K) + ((size_t)(b * 8 + head) * KVL + pos) * 192 + half * 64, v);
    } else {
      store64bf((bf16_t*)(p.ws + OFF_ACTA) + ((size_t)(b * 8 + head) * KVL + pos) * 128 + half * 64, v);
    }
  }
  __syncthreads();
}

constexpr float ASCALE = 0.07216878364870322f;
constexpr float ATHR = 8.f;
constexpr int KROW = 400;
constexpr int K_LDS_BYTES = 64 * KROW;
constexpr int V_LDS_BYTES = 64 * 128 * 2;

DEVI void partialSM(f32x16& p0, f32x16& p1, float& m_reg, float& mn, float& alpha) {
  constexpr float L2E = 1.4426950408889634f;
  float pmax = p0[0];
#pragma unroll
  for (int r = 1; r < 16; ++r) pmax = fmaxf(pmax, p0[r]);
#pragma unroll
  for (int r = 0; r < 16; ++r) pmax = fmaxf(pmax, p1[r]);
  { auto rr = __builtin_amdgcn_permlane32_swap(__float_as_uint(pmax), __float_as_uint(pmax), false, false);
    pmax = fmaxf(__uint_as_float(rr[0]), __uint_as_float(rr[1])); }
  if (__builtin_expect(__all(pmax - m_reg <= ATHR * L2E), 1)) { mn = m_reg; alpha = 1.f; }
  else { mn = fmaxf(m_reg, pmax); alpha = __builtin_amdgcn_exp2f(m_reg - mn); m_reg = mn; }
#pragma unroll
  for (int r = 0; r < 16; ++r) p0[r] = __builtin_amdgcn_exp2f(p0[r] - mn);
#pragma unroll
  for (int r = 0; r < 16; ++r) p1[r] = __builtin_amdgcn_exp2f(p1[r] - mn);
}
DEVI void finishSM(f32x16& p0, f32x16& p1, float alpha, float& l_reg, bf16x8& pa0, bf16x8& pa1, bf16x8& pa2, bf16x8& pa3) {
  float ps = 0;
#pragma unroll
  for (int r = 0; r < 16; ++r) ps += p0[r];
#pragma unroll
  for (int r = 0; r < 16; ++r) ps += p1[r];
  { auto rr = __builtin_amdgcn_permlane32_swap(__float_as_uint(ps), __float_as_uint(ps), false, false);
    ps = __uint_as_float(rr[0]) + __uint_as_float(rr[1]); }
  l_reg = l_reg * alpha + ps;
#define PK4(P, BASE, OUT) do { unsigned a0 = cvtpk(P[BASE + 0], P[BASE + 1]), a1 = cvtpk(P[BASE + 2], P[BASE + 3]);   \
    unsigned b0 = cvtpk(P[BASE + 4], P[BASE + 5]), b1 = cvtpk(P[BASE + 6], P[BASE + 7]);                              \
    auto r0 = __builtin_amdgcn_permlane32_swap(a0, b0, false, false); auto r1 = __builtin_amdgcn_permlane32_swap(a1, b1, false, false); \
    u32x4 w = {r0[0], r1[0], r0[1], r1[1]}; OUT = *reinterpret_cast<bf16x8*>(&w); } while (0)
  PK4(p0, 0, pa0); PK4(p0, 8, pa1); PK4(p1, 0, pa2); PK4(p1, 8, pa3);
#undef PK4
}
DEVI int v_st(int k) { const int kk = (k & ~0xC) | ((k & 4) << 1) | ((k & 8) >> 1); return ((kk >> 3) * 4) * 512 + ((kk & 7) * 32) * 2; }
DEVI int v_rd_base(int lane) { return ((lane & 3) << 3) | (((lane >> 2) & 3) << 6) | (((lane >> 4) & 1) << 5) | (((lane >> 5) & 1) << 8); }
constexpr int v_rd_off(int d0, int ks, int half) { return d0 * 512 + ks * 4096 + half * 2048; }
template <int OFF> DEVI s16x4 tr_read(int vb) {
  s16x4 r; asm volatile("ds_read_b64_tr_b16 %0, %1 offset:%2" : "=&v"(r) : "v"(vb), "i"(OFF) : "memory"); return r;
}
template <int D0> DEVI void pv_one(f32x16& od, int vb, bf16x8 pa0, bf16x8 pa1, bf16x8 pa2, bf16x8 pa3) {
  const s16x4 l0 = tr_read<v_rd_off(D0, 0, 0)>(vb), h0 = tr_read<v_rd_off(D0, 0, 1)>(vb), l1 = tr_read<v_rd_off(D0, 1, 0)>(vb), h1 = tr_read<v_rd_off(D0, 1, 1)>(vb);
  const s16x4 l2 = tr_read<v_rd_off(D0, 2, 0)>(vb), h2 = tr_read<v_rd_off(D0, 2, 1)>(vb), l3 = tr_read<v_rd_off(D0, 3, 0)>(vb), h3 = tr_read<v_rd_off(D0, 3, 1)>(vb);
  asm volatile("s_waitcnt lgkmcnt(0)" ::: "memory"); SBAR();
#define PK(L, H) (bf16x8){L[0], L[1], L[2], L[3], H[0], H[1], H[2], H[3]}
  od = __builtin_amdgcn_mfma_f32_32x32x16_bf16(pa0, PK(l0, h0), od, 0, 0, 0);
  od = __builtin_amdgcn_mfma_f32_32x32x16_bf16(pa1, PK(l1, h1), od, 0, 0, 0);
  od = __builtin_amdgcn_mfma_f32_32x32x16_bf16(pa2, PK(l2, h2), od, 0, 0, 0);
  od = __builtin_amdgcn_mfma_f32_32x32x16_bf16(pa3, PK(l3, h3), od, 0, 0, 0);
#undef PK
}

template <bool FIXED>
DEVI void attn_task(const bf16_t* __restrict__ Qb, const bf16_t* __restrict__ Kh, const bf16_t* __restrict__ Vh, bf16_t* __restrict__ Ob, char* lds, float shiftC) {
  const int tid = tid_(), wid = tid >> 6, lane = tid & 63, r32 = lane & 31, hi = lane >> 5;
  const int wu = __builtin_amdgcn_readfirstlane(wid);
  char* K_lds = lds; char* V_lds = lds + 24576;
  float* wsf = (float*)(lds + 24576 + 16384) + wid * 64; float* li_l = wsf; float* al_l = wsf + 32;
  float m_reg = -1e30f, l_reg = 0.f;
  f32x16 o[4] = {};
  bf16x8 qr[12];
  {
    const char* Qc = (const char*)Qb;
    const unsigned qoff = (unsigned)((wid * 32 + r32) * 192 + hi * 8) * 2u;
#pragma unroll
    for (int d0 = 0; d0 < 12; ++d0) qr[d0] = *(const bf16x8*)(Qc + (qoff + d0 * 32));
  }
  const char* Kc = (const char*)Kh; const char* Vc = (const char*)Vh;
  unsigned ksrc[6], vsrc[4];
#pragma unroll
  for (int e = 0; e < 6; ++e) {
    const unsigned byte = (unsigned)((wu * 6 + e) * 1024 + lane * 16);
    const unsigned r = byte / 384u, cpos = (byte - r * 384u) >> 4;
    ksrc[e] = r * 384u + (((cpos & ~7u) | ((cpos & 7u) ^ ((r >> 1) & 7u))) << 4);
  }
#pragma unroll
  for (int e = 0; e < 4; ++e) {
    const int st = 2 * (wu * 4 + e) + (lane >> 5);
    const int kk = (st >> 2) * 8 + ((lane & 31) >> 2), c = (st & 3) * 32 + (lane & 3) * 8;
    const int k = (kk & ~0xC) | ((kk & 4) << 1) | ((kk & 8) >> 1);
    vsrc[e] = (unsigned)(k * 256 + c * 2);
  }
#define KISSUE(k0) do { const char* kp_ = Kc + (size_t)(k0) * 384; _Pragma("unroll") for (int e = 0; e < 6; ++e) \
      __builtin_amdgcn_global_load_lds((const unsigned*)(kp_ + ksrc[e]), (unsigned*)(K_lds + (wu * 6 + e) * 1024), 16, 0, 0); } while (0)
#define VISSUE(k0) do { const char* vp_ = Vc + (size_t)(k0) * 256; _Pragma("unroll") for (int e = 0; e < 4; ++e) \
      __builtin_amdgcn_global_load_lds((const unsigned*)(vp_ + vsrc[e]), (unsigned*)(V_lds + (wu * 4 + e) * 1024), 16, 0, 0); } while (0)
#define ABAR() do { asm volatile("s_waitcnt vmcnt(0) lgkmcnt(0)" ::: "memory"); __builtin_amdgcn_s_barrier(); } while (0)
  const int vb0 = (int)(uintptr_t)V_lds + v_rd_base(lane);
  const int swz = (r32 >> 1) & 7;
  int kx[4];
#pragma unroll
  for (int i = 0; i < 4; ++i) kx[i] = ((2 * i + hi) ^ swz) << 4;
  const char* Kr0 = K_lds + r32 * 384;
  KISSUE(0); VISSUE(0); ABAR();
  constexpr int NT = KVL / 64;
  for (int j = 0; j < NT; ++j) {
    f32x16 p0 = {}, p1 = {};
#pragma unroll
    for (int d0 = 0; d0 < 12; ++d0) {
      const bf16x8 b0 = *(const bf16x8*)(Kr0 + (d0 >> 2) * 128 + kx[d0 & 3]);
      const bf16x8 b1 = *(const bf16x8*)(Kr0 + 32 * 384 + (d0 >> 2) * 128 + kx[d0 & 3]);
      p0 = __builtin_amdgcn_mfma_f32_32x32x16_bf16(b0, qr[d0], p0, 0, 0, 0);
      p1 = __builtin_amdgcn_mfma_f32_32x32x16_bf16(b1, qr[d0], p1, 0, 0, 0);
    }
    ABAR();
    if (j + 1 < NT) KISSUE((j + 1) * 64);
    float mn, alpha = 1.f;
    if constexpr (FIXED) {
#pragma unroll
      for (int r = 0; r < 16; ++r) p0[r] = __builtin_amdgcn_exp2f(p0[r]);
#pragma unroll
      for (int r = 0; r < 16; ++r) p1[r] = __builtin_amdgcn_exp2f(p1[r]);
    } else partialSM(p0, p1, m_reg, mn, alpha);
    if (!FIXED && __any(alpha < 1.f)) {
      if (hi == 0) al_l[r32] = alpha;
      asm volatile("s_waitcnt lgkmcnt(0)" ::: "memory");
#pragma unroll
      for (int r = 0; r < 16; ++r) { const float a = al_l[crow(r, hi)];
#pragma unroll
        for (int d = 0; d < 4; ++d) o[d][r] *= a; }
    }
    bf16x8 pa0, pa1, pa2, pa3;
    finishSM(p0, p1, alpha, l_reg, pa0, pa1, pa2, pa3);
    pv_one<0>(o[0], vb0, pa0, pa1, pa2, pa3); pv_one<1>(o[1], vb0, pa0, pa1, pa2, pa3);
    pv_one<2>(o[2], vb0, pa0, pa1, pa2, pa3); pv_one<3>(o[3], vb0, pa0, pa1, pa2, pa3);
    ABAR();
    if (j + 1 < NT) VISSUE((j + 1) * 64);
  }
#undef KISSUE
#undef VISSUE
#undef ABAR
  if (hi == 0) li_l[r32] = l_reg;
  asm volatile("s_waitcnt lgkmcnt(0)" ::: "memory");
  char* Oc = (char*)Ob;
#pragma unroll
  for (int r = 0; r < 16; ++r) {
    const int orow = crow(r, hi);
    const float rl = 1.f / li_l[orow];
    const unsigned ooff = (unsigned)((wid * 32 + orow) * LDP + r32) * 2u;
#pragma unroll
    for (int d0 = 0; d0 < 4; ++d0) *(bf16_t*)(Oc + (ooff + d0 * 64)) = f2bf(o[d0][r] * rl);
  }
  __syncthreads();
}

#define XB_TMO      128
#define XB_XCNT(j)  (256  + 64 * (j))
#define XB_XSUB(j)  (1280 + 64 * (j))
#define XB_XGEN(j)  (2304 + 64 * (j))
#define XB_TOP      3328
#define XB_TOPGEN   3392
#define XCD_BAR_WORDS 3456
#define XB_SPIN_CAP (1u << 24)
#define LAS __attribute__((address_space(3)))
DEVI unsigned xb_ld(unsigned* p)              { return __hip_atomic_load(p, __ATOMIC_RELAXED, __HIP_MEMORY_SCOPE_AGENT); }
DEVI unsigned xb_add(unsigned* p, unsigned v) { return __hip_atomic_fetch_add(p, v, __ATOMIC_RELAXED, __HIP_MEMORY_SCOPE_AGENT); }
DEVI unsigned xb_xcc_id() { return (unsigned)__builtin_amdgcn_s_getreg((3 << 11) | 20) & 0xFu; }
#define XB_SPIN(cond, bar) do { unsigned _sp = 0; while (cond) { __builtin_amdgcn_s_sleep(1); \
    if ((++_sp & 255u) == 0u) { if (xb_ld(&(bar)[XB_TMO])) break; if (_sp > XB_SPIN_CAP) { atomicAdd(&(bar)[XB_TMO], 1u); break; } } } } while (0)
struct XcdBarrier { unsigned* bar; unsigned x; volatile LAS unsigned* st; };
DEVI XcdBarrier xcd_barrier_post(unsigned* bar, volatile LAS unsigned* st) {
  XcdBarrier b; b.bar = bar; b.x = xb_xcc_id(); b.st = st;
  if (threadIdx.x == 0) (void)xb_add(&bar[XB_XCNT(b.x)], 1u);
  return b;
}
DEVI void xcd_barrier_complete(unsigned* bar, unsigned x, unsigned& nloc, unsigned& nx) {
  const unsigned G = gridDim.x * gridDim.y * gridDim.z;
  unsigned sum, cnt, mine, sp = 0u;
  for (;;) {
    sum = 0u; cnt = 0u; mine = 0u;
#pragma unroll
    for (unsigned j = 0; j < 16; ++j) { const unsigned c = xb_ld(&bar[XB_XCNT(j)]); sum += c; cnt += (c > 0u) ? 1u : 0u; mine = (j == x) ? c : mine; }
    if (sum == G) break;
    __builtin_amdgcn_s_sleep(1);
    if ((++sp & 255u) == 0u) { if (xb_ld(&bar[XB_TMO])) break; if (sp > XB_SPIN_CAP) { atomicAdd(&bar[XB_TMO], 1u); break; } }
  }
  nloc = mine > 0u ? mine : 1u; nx = cnt > 0u ? cnt : 1u;
}
DEVI void xcd_barrier(const XcdBarrier& b) {
  asm volatile("s_waitcnt vmcnt(0)" ::: "memory");
  __syncthreads();
  if (threadIdx.x == 0) {
    unsigned* bar = b.bar;
    __builtin_amdgcn_s_waitcnt(0);
    unsigned nloc = b.st[0], nx = b.st[1];
    if (nloc == 0u) { xcd_barrier_complete(bar, b.x, nloc, nx); b.st[0] = nloc; b.st[1] = nx; }
    const unsigned old = xb_add(&bar[XB_XSUB(b.x)], 1u);
    const unsigned gen = old / nloc;
    if (old + 1u == (gen + 1u) * nloc) {
      __builtin_amdgcn_fence(__ATOMIC_RELEASE, "agent");
      asm volatile("s_waitcnt vmcnt(0)" ::: "memory");
      const unsigned og = xb_add(&bar[XB_TOP], 1u);
      const unsigned tg = og / nx;
      if (og + 1u == (tg + 1u) * nx) xb_add(&bar[XB_TOPGEN], 1u);
      else XB_SPIN(xb_ld(&bar[XB_TOPGEN]) == tg, bar);
      __builtin_amdgcn_fence(__ATOMIC_ACQUIRE, "agent");
      xb_add(&bar[XB_XGEN(b.x)], 1u);
      asm volatile("s_waitcnt vmcnt(0)" ::: "memory");
    } else {
      XB_SPIN(xb_ld(&bar[XB_XGEN(b.x)]) == gen, bar);
      __builtin_amdgcn_fence(__ATOMIC_ACQUIRE, "agent");
      asm volatile("s_waitcnt vmcnt(0)" ::: "memory");
    }
  }
  __syncthreads();
}

#define GEMM_LOOP(MT, NT, SM, SN, ...) \
  { const int xcd_ = blockIdx.x & 7, nbs_ = gridDim.x >> 3; constexpr int SNT_ = ((NT) + (SN) - 1) / (SN), SMT_ = ((MT) + (SM) - 1) / (SM); \
    for (int w_ = blockIdx.x >> 3;; w_ += nbs_) { const int s_ = (w_ >> 6) * 8 + xcd_; if (s_ >= SMT_ * SNT_) break; const int slot_ = w_ & 63; \
      if (slot_ >= (SM) * (SN)) continue; \
      const int tm = (s_ / SNT_) * (SM) + slot_ / (SN), tn = (s_ % SNT_) * (SN) + slot_ % (SN); if (tm >= (MT) || tn >= (NT)) continue; __VA_ARGS__ } }

template <int PH>
DEVI void run_phase(const Params& p, char* lds) {
  unsigned char* ws = p.ws;
  const bf16_t* ACTA = (const bf16_t*)(ws + OFF_ACTA);
  const bf16_t* ACTB = (const bf16_t*)(ws + OFF_ACTB);
  float* ctxr = (float*)(ws + OFF_CTXR);
  if constexpr (PH == 0) phase_prep(p, lds);
  if constexpr (PH == 1) phase_norm(p, p.in[0], p.in[2], p.in[6], 0, 0, 1, NTOK);
  if constexpr (PH == 2) phase_s5_state(p);
  if constexpr (PH == 3) phase_s5_carry(p);
  if constexpr (PH == 4) phase_s5<true>(p, lds);
  if constexpr (PH == 5)
    GEMM_LOOP(264, 16, 8, 8, { gemm_tile<EPI_GLU, false>(p, ACTB, LDP, (const bf16_t*)(ws + OFF_WGLU), LDP, DM, tm * 128, 0, 0, tn, 0, 0, lds); })
  if constexpr (PH == 6) phase_norm(p, p.out, ctxr, p.in[7], 0, 3, 4, NTOK);
  if constexpr (PH == 7)
    GEMM_LOOP(270, 44, 16, 4, {
      const int rb = tm < 261 ? tm * 126 - 1 : NLAT + (tm - 261) * 126 - 1;
      const int lo = tm < 261 ? 0 : NLAT, hi = tm < 261 ? NLAT : NTOK;
      gemm_tile<EPI_FFNIN, true>(p, ACTA, LDP, (const bf16_t*)(ws + OFF_WFIN), LDP, DM, rb, lo, hi, tn, 0, 0, lds);
    })
  if constexpr (PH == 8)
    GEMM_LOOP(264, 8, 8, 8, { gemm_tile<EPI_RES, false>(p, (const bf16_t*)(ws + OFF_X), FF, (const bf16_t*)(ws + OFF_WFOUT), FF, FF, tm * 128, 0, 0, tn, 0, 5, lds); })
  if constexpr (PH == 9) phase_norm(p, p.out, ctxr, p.in[6] + DM, 1, 0, 1, NTOK);
  if constexpr (PH == 10)
    GEMM_LOOP(264, 9, 21, 3, { gemm_tile<EPI_G1, false>(p, ACTA, LDP, (const bf16_t*)(ws + OFF_WD), LDP, DM, tm * 128, 0, 0, tn, 1, 0, lds); })
  if constexpr (PH == 11)
    GEMM_LOOP(256, 12, 16, 4, { gemm_tile<EPI_Q, false>(p, (const bf16_t*)(ws + OFF_Y), 1152, (const bf16_t*)(ws + OFF_WUQ), 768, 768, tm * 128, 0, 0, tn, 1, 0, lds); })
  if constexpr (PH == 12)
    GEMM_LOOP(264, 16, 8, 8, { gemm_tile<EPI_KV, false>(p, (const bf16_t*)(ws + OFF_Y) + 768, 1152, (const bf16_t*)(ws + OFF_WUKV), 256, 256, tm * 128, 0, 0, tn, 1, 0, lds); })
  if constexpr (PH == 13) {
    float sbound;
    {
      const int ln = tid_() & 63;
      float mq = fmaxf(fabsf(p.in[24][ln]), fabsf(p.in[24][64 + ln])), mk = fmaxf(fabsf(p.in[26][ln]), fabsf(p.in[26][64 + ln]));
      float mqr = fabsf(p.in[25][ln]), mkr = fabsf(p.in[27][ln]);
#pragma unroll
      for (int o_ = 32; o_; o_ >>= 1) { mq = fmaxf(mq, __shfl_xor(mq, o_)); mk = fmaxf(mk, __shfl_xor(mk, o_)); mqr = fmaxf(mqr, __shfl_xor(mqr, o_)); mkr = fmaxf(mkr, __shfl_xor(mkr, o_)); }
      sbound = __int_as_float(__builtin_amdgcn_readfirstlane(__float_as_int(ASCALE * (128.f * mq * mk + 64.f * mqr * mkr) * 1.02f)));
    }
    for (int v = blockIdx.x; v < 2048; v += gridDim.x) {
      const int bh = (v >> 9) * 8 + (v & 7), qb = (v & 511) >> 3;
      const int b = bh >> 3, h = bh & 7;
      const bf16_t* Qp = (const bf16_t*)(ws + OFF_X) + ((size_t)bh * SEQL + qb * 128) * 192;
      const bf16_t* Kp = (const bf16_t*)(ws + OFF_K) + (size_t)bh * KVL * 192;
      const bf16_t* Vp = (const bf16_t*)(ws + OFF_ACTA) + (size_t)bh * KVL * 128;
      bf16_t* Op = (bf16_t*)(ws + OFF_ACTB) + ((size_t)(b * SEQL + qb * 128)) * LDP + h * 128;
      if (sbound <= 60.f) attn_task<true>(Qp, Kp, Vp, Op, lds, -sbound * 1.4426950408889634f);
      else attn_task<false>(Qp, Kp, Vp, Op, lds, 0.f);
    }
  }
  if constexpr (PH == 14)
    GEMM_LOOP(256, 8, 8, 8, { gemm_tile<EPI_RES, false>(p, ACTB, LDP, (const bf16_t*)(ws + OFF_WO), LDP, DM, tm * 128, 0, 0, tn, 1, 2, lds); })
  if constexpr (PH == 15) phase_norm(p, p.out, ctxr, p.in[7] + DM, 1, 3, 4, NLAT);
  if constexpr (PH == 16)
    GEMM_LOOP(261, 44, 16, 4, { gemm_tile<EPI_FFNIN, true>(p, ACTA, LDP, (const bf16_t*)(ws + OFF_WFIN + WFIN_BYTES), LDP, DM, tm * 126 - 1, 0, NLAT, tn, 1, 0, lds); })
  if constexpr (PH == 17)
    GEMM_LOOP(256, 8, 8, 8, { gemm_tile<EPI_RES, false>(p, (const bf16_t*)(ws + OFF_X), FF, (const bf16_t*)(ws + OFF_WFOUT + 5767168), FF, FF, tm * 128, 0, 0, tn, 1, 5, lds); })
}

#ifndef PHMASK
#define PHMASK 0x3ffff
#endif
#ifndef PROBE_MASK
#define PROBE_MASK 0
#endif
#define RUNP(N) do { if ((PHMASK >> N) & 1) { if ((PROBE_MASK >> N) & 1) { for (int r_ = 0; r_ < p.pad0; ++r_) { run_phase<N>(p, lds); SYNCG(); } } else run_phase<N>(p, lds); } } while (0)
#define SYNCG() xcd_barrier(xb)
__global__ void __launch_bounds__(256, 2) mega(Params p) {
  extern __shared__ __attribute__((aligned(16))) char lds[];
  volatile LAS unsigned* xst = (volatile LAS unsigned*)(lds + LDS_BYTES - 16);
  if (threadIdx.x == 0) { xst[0] = 0u; xst[1] = 0u; }
  __syncthreads();
  const XcdBarrier xb = xcd_barrier_post((unsigned*)(p.ws + OFF_BAR), xst);
  if (p.pad1) cg::this_grid().sync();
  RUNP(0); SYNCG(); RUNP(1); SYNCG(); RUNP(2); SYNCG(); RUNP(3); SYNCG(); RUNP(4); SYNCG(); RUNP(5); SYNCG();
  RUNP(6); SYNCG(); RUNP(7); SYNCG(); RUNP(8); SYNCG(); RUNP(9); SYNCG(); RUNP(10); SYNCG(); RUNP(11); RUNP(12); SYNCG();
  RUNP(13); SYNCG(); RUNP(14); SYNCG(); RUNP(15); SYNCG(); RUNP(16); SYNCG(); RUNP(17);
}
template <int PH>
__global__ void __launch_bounds__(256, 2) phase_kernel(Params p) {
  extern __shared__ __attribute__((aligned(16))) char lds[];
  run_phase<PH>(p, lds);
}


extern "C" void kernel_launch(void* const* d_in, const int* in_sizes, int n_in, void* d_out, int out_size, void* d_ws, size_t ws_size, hipStream_t stream) {
  static int grid_blocks = 0;
  if (grid_blocks == 0) {
    if (n_in != 33 || out_size != NLAT * DM || ws_size < WS_END) {
      fprintf(stderr, "kernel_launch: unexpected shapes n_in %d out %d ws %zu (need %zu)\n", n_in, out_size, ws_size, (size_t)WS_END);
      grid_blocks = -1; return;
    }
    int dev = 0, cus = 0, per_cu = 0;
    hipGetDevice(&dev);
    hipDeviceGetAttribute(&cus, hipDeviceAttributeMultiprocessorCount, dev);
    if (hipFuncSetAttribute((const void*)mega, hipFuncAttributeMaxDynamicSharedMemorySize, LDS_BYTES) != hipSuccess) {
      fprintf(stderr, "kernel_launch: hipFuncSetAttribute failed\n"); grid_blocks = -1; return; }
    hipOccupancyMaxActiveBlocksPerMultiprocessor(&per_cu, (const void*)mega, 256, LDS_BYTES);
    if (per_cu < 1) { fprintf(stderr, "kernel_launch: occupancy query returned %d\n", per_cu); per_cu = 1; }
    if (per_cu > 2) per_cu = 2;
    grid_blocks = cus * per_cu;
    (void)hipGetLastError();
  }
  if (grid_blocks < 0) return;
  Params p{};
  for (int i = 0; i < 33; ++i) p.in[i] = (const float*)d_in[i];
  p.out = (float*)d_out; p.ws = (unsigned char*)d_ws; p.pad0 = 2;
#if ONE_LAUNCH
  if (hipMemsetAsync((char*)d_ws + OFF_BAR, 0, XCD_BAR_WORDS * 4, stream) != hipSuccess) { fprintf(stderr, "memset failed\n"); return; }
  void* args[] = {&p};
  hipError_t e = hipLaunchCooperativeKernel((const void*)mega, dim3(grid_blocks), dim3(256), args, LDS_BYTES, stream);
  if (e != hipSuccess) fprintf(stderr, "cooperative launch failed: %s (grid %d)\n", hipGetErrorString(e), grid_blocks);
#else
#define LP(N) hipLaunchKernelGGL(phase_kernel<N>, dim3(grid_blocks), dim3(256), LDS_BYTES, stream, p)
  LP(0); LP(1); LP(2); LP(3); LP(4); LP(5); LP(6); LP(7); LP(8); LP(9); LP(10); LP(11); LP(12); LP(13); LP(14); LP(15); LP(16); LP(17);
#undef LP
#endif
}
```

```cpp
#include <hip/hip_runtime.h>
#include <hip/hip_cooperative_groups.h>
#include <cstdio>
#include <cstdint>
namespace cg = cooperative_groups;

#ifndef ONE_LAUNCH
#define ONE_LAUNCH 1
#endif

typedef unsigned short bf16_t;
using bf16x8 = __attribute__((ext_vector_type(8))) short;
using s16x4  = __attribute__((ext_vector_type(4))) short;
using f32x16 = __attribute__((ext_vector_type(16))) float;
using f32x4  = __attribute__((ext_vector_type(4))) float;
using u32x4  = __attribute__((ext_vector_type(4))) unsigned;
using u32x2  = __attribute__((ext_vector_type(2))) unsigned;

#define DEVI __device__ __forceinline__
#define SBAR() __builtin_amdgcn_sched_barrier(0)

constexpr int DM = 1024, NB = 4, SEQL = 8192, CTXL = 256;
constexpr int NLAT = NB * SEQL;
constexpr int NCTX = NB * CTXL;
constexpr int NTOK = NLAT + NCTX;
constexpr int FF = 2816;
constexpr int KVL = SEQL + CTXL;
constexpr int NCHUNK = 264;
constexpr float EPSN = 1e-6f;
constexpr int LDS_BYTES = 67584 + 16;
constexpr int LDP = 1088;

constexpr size_t OFF_MOD   = 0;
constexpr size_t OFF_S5AB  = OFF_MOD + 245760;
constexpr size_t OFF_ROPE  = OFF_S5AB + 131072;
constexpr size_t OFF_BBF   = OFF_ROPE + 16384;
constexpr size_t OFF_CMF   = OFF_BBF + 524288;
constexpr size_t OFF_WGLU  = OFF_CMF + 524288;
constexpr size_t OFF_WFIN  = OFF_WGLU + 4456448;
constexpr size_t WFIN_BYTES = 12255232;
constexpr size_t OFF_WFOUT = OFF_WFIN + 2 * WFIN_BYTES;
constexpr size_t OFF_WD    = OFF_WFOUT + 2 * 5767168;
constexpr size_t OFF_WUQ   = OFF_WD + 2506752;
constexpr size_t OFF_WUKV  = OFF_WUQ + 2359296;
constexpr size_t OFF_WO    = OFF_WUKV + 1048576;
constexpr size_t OFF_SSQ   = OFF_WO + 2228224;
constexpr size_t OFF_CTXR  = OFF_SSQ + 1081344;
constexpr size_t OFF_ACTA  = OFF_CTXR + 4194304;
constexpr size_t OFF_ACTB  = OFF_ACTA + 73531392;
constexpr size_t OFF_Y     = OFF_ACTB + 73531392;
constexpr size_t OFF_X     = OFF_Y + 77856768;
constexpr size_t OFF_K     = OFF_X + 100663296;
constexpr size_t OFF_BAR   = OFF_X + 204472320;
constexpr size_t OFF_Q     = OFF_BAR + 16384;
constexpr size_t WS_END    = OFF_Q + 16384;

struct Params {
  const float* in[33];
  float* out;
  unsigned char* ws;
  int pad0, pad1;
};

DEVI unsigned cvtpk(float lo, float hi) { unsigned r; asm("v_cvt_pk_bf16_f32 %0, %1, %2" : "=v"(r) : "v"(lo), "v"(hi)); return r; }
DEVI bf16_t f2bf(float x) { return (bf16_t)(cvtpk(x, 0.f) & 0xffffu); }
DEVI float bf2f(bf16_t b) { return __uint_as_float(((unsigned)b) << 16); }
DEVI int tid_() { int t = threadIdx.x; asm volatile("" : "+v"(t)); return t; }
DEVI int crow(int r, int hi) { return (r & 3) + 8 * (r >> 2) + 4 * hi; }
DEVI float wave_sum(float v) {
#pragma unroll
  for (int o = 32; o; o >>= 1) v += __shfl_xor(v, o);
  return v;
}
DEVI float sigmoidf_(float x) { return 1.f / (1.f + __expf(-x)); }
DEVI float gelu_tanh(float x) {
  float u = 0.7978845608028654f * (x + 0.044715f * x * x * x);
  float t = 1.f - 2.f / (1.f + __expf(2.f * u));
  return 0.5f * x * (1.f + t);
}

DEVI int permrow(int perm, int n) {
  if (perm == 1) { int g = n >= 1024; int j = g ? n - 1024 : n; return (j >> 5) * 64 + g * 32 + (j & 31); }
  if (perm == 2) { int g = n >= FF; int j = g ? n - FF : n; return (j >> 5) * 64 + g * 32 + (j & 31); }
  if (perm == 3) { int h = n / 192, d = n - h * 192; return d < 128 ? h * 128 + d : 1024 + h * 64 + (d - 128); }
  return n;
}

DEVI void prep_transpose(int t, const float* src, int K, int N, bf16_t* dst, int ld, int perm, const float* scale, char* lds) {
  const int tid = tid_();
  float* tl = (float*)lds;
  const int ntn = N >> 6;
  const int tk = t / ntn, tn = t - tk * ntn;
  const int k0 = tk * 64, n0 = tn * 64;
#pragma unroll
  for (int e = 0; e < 16; ++e) {
    int idx = e * 256 + tid, i = idx >> 6, j = idx & 63;
    float v = src[(size_t)(k0 + i) * N + n0 + j];
    if (scale) v *= scale[k0 + i];
    tl[i * 65 + j] = v;
  }
  __syncthreads();
#pragma unroll
  for (int e = 0; e < 8; ++e) {
    int idx = e * 256 + tid, j = idx >> 5, ip = idx & 31;
    unsigned w = cvtpk(tl[(2 * ip) * 65 + j], tl[(2 * ip + 1) * 65 + j]);
    int nr = permrow(perm, n0 + j);
    *(unsigned*)(dst + (size_t)nr * ld + k0 + 2 * ip) = w;
  }
  __syncthreads();
}

constexpr int T_ADA = 384, T_TR = 5680, T_S5 = 32;
constexpr int T_TOTAL = T_ADA + T_TR + T_S5 + 2;

DEVI void phase_prep(const Params& p, char* lds) {
  const int tid = tid_();
  unsigned char* ws = p.ws;
  for (int idx = blockIdx.x; idx < T_TOTAL; idx += gridDim.x) {
    if (idx < T_ADA) {
      float* sl = (float*)lds;
      float* red = sl + 5 * 1024;
      for (int e = tid; e < 5 * 1024; e += 256) {
        int r = e >> 10, k = e & 1023;
        float c = r < 4 ? p.in[1][r * 1024 + k] : p.in[3][k];
        sl[e] = c * sigmoidf_(c);
      }
      __syncthreads();
      const int layer = idx / 192, cg_ = idx - layer * 192;
      const int cl = tid & 31, ks = tid >> 5;
      const int col = cg_ * 32 + cl;
      const float* w = p.in[4] + (size_t)layer * 1024 * 6144 + col;
      float a0 = 0, a1 = 0, a2 = 0, a3 = 0, a4 = 0;
#pragma unroll 8
      for (int k = ks * 128; k < ks * 128 + 128; ++k) {
        float wv = w[(size_t)k * 6144];
        a0 += sl[k] * wv; a1 += sl[1024 + k] * wv; a2 += sl[2048 + k] * wv; a3 += sl[3072 + k] * wv; a4 += sl[4096 + k] * wv;
      }
      red[(ks * 5 + 0) * 32 + cl] = a0; red[(ks * 5 + 1) * 32 + cl] = a1; red[(ks * 5 + 2) * 32 + cl] = a2;
      red[(ks * 5 + 3) * 32 + cl] = a3; red[(ks * 5 + 4) * 32 + cl] = a4;
      __syncthreads();
      if (tid < 160) {
        int r = tid >> 5, c2 = tid & 31;
        float s = 0;
#pragma unroll
        for (int q = 0; q < 8; ++q) s += red[(q * 5 + r) * 32 + c2];
        int cc = cg_ * 32 + c2;
        ((float*)(ws + OFF_MOD))[(layer * 5 + r) * 6144 + cc] = s + p.in[5][layer * 6144 + cc];
      }
      __syncthreads();
    } else if (idx < T_ADA + T_TR) {
      int t = idx - T_ADA;
      const float* tsrc; int tK, tN, tperm; bf16_t* tdst; const float* tscale = nullptr;
      if (t < 512) { tsrc = p.in[16]; tK = 1024; tN = 2048; tdst = (bf16_t*)(ws + OFF_WGLU); tperm = 1; }
      else if ((t -= 512) < 1408) { tsrc = p.in[29]; tK = 1024; tN = 5632; tdst = (bf16_t*)(ws + OFF_WFIN); tperm = 2; }
      else if ((t -= 1408) < 1408) { tsrc = p.in[29] + (size_t)1024 * 5632; tK = 1024; tN = 5632; tdst = (bf16_t*)(ws + OFF_WFIN + WFIN_BYTES); tperm = 2; }
      else if ((t -= 1408) < 704) { tsrc = p.in[32]; tK = 2816; tN = 1024; tdst = (bf16_t*)(ws + OFF_WFOUT); tperm = 0; }
      else if ((t -= 704) < 704) { tsrc = p.in[32] + (size_t)2816 * 1024; tK = 2816; tN = 1024; tdst = (bf16_t*)(ws + OFF_WFOUT + 5767168); tperm = 0; }
      else if ((t -= 704) < 192) { tsrc = p.in[18]; tK = 1024; tN = 768; tdst = (bf16_t*)(ws + OFF_WD); tperm = 0; }
      else if ((t -= 192) < 80) { tsrc = p.in[21]; tK = 1024; tN = 320; tdst = (bf16_t*)(ws + OFF_WD) + (size_t)768 * LDP; tperm = 0; }
      else if ((t -= 80) < 288) { tsrc = p.in[20]; tK = 768; tN = 1536; tdst = (bf16_t*)(ws + OFF_WUQ); tperm = 3; tscale = p.in[19]; }
      else if ((t -= 288) < 128) { tsrc = p.in[23]; tK = 256; tN = 2048; tdst = (bf16_t*)(ws + OFF_WUKV); tperm = 0; tscale = p.in[22]; }
      else { t -= 128; tsrc = p.in[28]; tK = 1024; tN = 1024; tdst = (bf16_t*)(ws + OFF_WO); tperm = 0; }
      prep_transpose(t, tsrc, tK, tN, tdst, tK == 1024 ? LDP : tK, tperm, tscale, lds);
    } else if (idx < T_ADA + T_TR + T_S5) {
      const int gid = (idx - T_ADA - T_TR) * 256 + tid;
      const int pp = gid & 63, dg = gid >> 6;
      const double dt = exp((double)p.in[10][dg]);
      const double lre = p.in[8][gid], lim = p.in[9][gid];
      const double mag = exp(lre * dt), ang = lim * dt;
      const double are = mag * cos(ang), aim = mag * sin(ang);
      const double den = lre * lre + lim * lim;
      const double zr = are - 1.0, zi = aim;
      const double fr = (zr * lre + zi * lim) / den, fi = (zi * lre - zr * lim) / den;
      double tr = are, ti = aim;
#pragma unroll
      for (int q = 0; q < 5; ++q) { double nr = tr * tr - ti * ti, ni = 2.0 * tr * ti; tr = nr; ti = ni; }
      float* tab = (float*)(ws + OFF_S5AB);
      tab[gid] = (float)are; tab[8192 + gid] = (float)aim; tab[16384 + gid] = (float)tr; tab[24576 + gid] = (float)ti;
      bf16_t* bbf = (bf16_t*)(ws + OFF_BBF);
      bf16_t* cmf = (bf16_t*)(ws + OFF_CMF);
      for (int c = 0; c < 16; ++c) {
        const double bre = p.in[11][(size_t)gid * 16 + c], bim = p.in[12][(size_t)gid * 16 + c];
        const float bbr = (float)(fr * bre - fi * bim), bbi = (float)(fr * bim + fi * bre);
        const int h = c >> 3, jj = c & 7, lane = h * 32 + (pp & 31);
        bbf[((size_t)(dg * 4 + (pp >> 5)) * 64 + lane) * 8 + jj] = f2bf(bbr);
        bbf[((size_t)(dg * 4 + 2 + (pp >> 5)) * 64 + lane) * 8 + jj] = f2bf(bbi);
        const float cre = p.in[13][((size_t)dg * 16 + c) * 64 + pp], cim = p.in[14][((size_t)dg * 16 + c) * 64 + pp];
        const int ks = pp >> 5, q = (pp & 31) >> 3, j2 = pp & 7, lane2 = q * 16 + c;
        cmf[((size_t)(dg * 4 + ks) * 64 + lane2) * 8 + j2] = f2bf(cre);
        cmf[((size_t)(dg * 4 + 2 + ks) * 64 + lane2) * 8 + j2] = f2bf(-cim);
      }
    } else if (idx == T_ADA + T_TR + T_S5) {
      float* rt = (float*)(ws + OFF_ROPE);
      for (int e = tid; e < 2048; e += 256) {
        int pos = e >> 4, i = e & 15;
        float inv = (float)pow(10000.0, -(double)i / 16.0);
        float ang = (float)pos * inv;
        rt[e * 2] = (float)cos((double)ang); rt[e * 2 + 1] = (float)sin((double)ang);
      }
    } else {
      u32x4 z = {0, 0, 0, 0};
      u32x4* d = (u32x4*)((bf16_t*)(ws + OFF_WD) + (size_t)1088 * LDP);
      for (int e = tid; e < 64 * LDP / 8; e += 256) d[e] = z;
    }
  }
}

DEVI void phase_norm(const Params& p, const float* src_lat, const float* src_ctx, const float* gn, int layer, int sh_idx, int sc_idx, int nrows) {
  const int lane = tid_() & 63, wid = tid_() >> 6;
  const float* mod = (const float*)(p.ws + OFF_MOD);
  bf16_t* dst = (bf16_t*)(p.ws + OFF_ACTA);
  for (int row = blockIdx.x * 4 + wid; row < nrows; row += gridDim.x * 4) {
    const float* s; int mr;
    if (row < NLAT) { s = src_lat + (size_t)row * DM; mr = row >> 13; } else { s = src_ctx + (size_t)(row - NLAT) * DM; mr = 4; }
    f32x4 v[4]; float ss = 0;
#pragma unroll
    for (int i = 0; i < 4; ++i) { v[i] = *(const f32x4*)(s + i * 256 + lane * 4); ss += v[i][0] * v[i][0] + v[i][1] * v[i][1] + v[i][2] * v[i][2] + v[i][3] * v[i][3]; }
    ss = wave_sum(ss);
    const float rs = rsqrtf(ss * (1.f / DM) + EPSN);
    const float* shp = mod + (layer * 5 + mr) * 6144 + sh_idx * 1024;
    const float* scp = mod + (layer * 5 + mr) * 6144 + sc_idx * 1024;
    f32x4 gg[4], shh[4], scc[4];
#pragma unroll
    for (int i = 0; i < 4; ++i) { const int c = i * 256 + lane * 4; gg[i] = *(const f32x4*)(gn + c); shh[i] = *(const f32x4*)(shp + c); scc[i] = *(const f32x4*)(scp + c); }
#pragma unroll
    for (int i = 0; i < 4; ++i) {
      const int c = i * 256 + lane * 4;
      float o0 = (v[i][0] * rs * gg[i][0]) * (1.f + scc[i][0]) + shh[i][0];
      float o1 = (v[i][1] * rs * gg[i][1]) * (1.f + scc[i][1]) + shh[i][1];
      float o2 = (v[i][2] * rs * gg[i][2]) * (1.f + scc[i][2]) + shh[i][2];
      float o3 = (v[i][3] * rs * gg[i][3]) * (1.f + scc[i][3]) + shh[i][3];
      u32x2 w = {cvtpk(o0, o1), cvtpk(o2, o3)};
      *(u32x2*)(dst + (size_t)row * LDP + c) = w;
    }
  }
}

template <bool PHASE_C>
DEVI void phase_s5(const Params& p, char* lds) {
  const int lane = tid_() & 63, wid = tid_() >> 6, r32 = lane & 31, hi = lane >> 5;
  float* wl = (float*)(lds + wid * 16896);
  const bf16_t* U = (const bf16_t*)(p.ws + OFF_ACTA);
  bf16_t* Z = (bf16_t*)(p.ws + OFF_ACTB);
  const float* tab = (const float*)(p.ws + OFF_S5AB);
  const bf16x8* bbf = (const bf16x8*)(p.ws + OFF_BBF);
  const bf16x8* cmf = (const bf16x8*)(p.ws + OFF_CMF);
  float* S = (float*)(p.ws + OFF_Y);
  for (int pc = blockIdx.x * 4 + wid; pc < NB * 64 * 8; pc += gridDim.x * 4) {
    const int pair = pc >> 3, sub = pc & 7, b = pair >> 6, g = pair & 63;
    bf16x8 bb[2][4], cm[2][4];
    float arr[2], aii[2];
#pragma unroll
    for (int d = 0; d < 2; ++d) {
      const int dg = d * 64 + g;
#pragma unroll
      for (int nt = 0; nt < 4; ++nt) bb[d][nt] = bbf[(size_t)(dg * 4 + nt) * 64 + lane];
      if (PHASE_C) {
#pragma unroll
        for (int ks = 0; ks < 4; ++ks) cm[d][ks] = cmf[(size_t)(dg * 4 + ks) * 64 + lane];
      }
      arr[d] = tab[dg * 64 + lane]; aii[d] = tab[8192 + dg * 64 + lane];
    }
    const float dsk = PHASE_C ? p.in[15][g * 16 + (lane & 15)] : 0.f;
   for (int kc = sub; kc < NCHUNK; kc += 8) {
    const int tok0 = kc < 256 ? b * SEQL + kc * 32 : NLAT + b * CTXL + (kc - 256) * 32;
    const bf16x8 afrag = *(const bf16x8*)(U + (size_t)(tok0 + r32) * LDP + g * 16 + hi * 8);
    f32x4 y0 = {0, 0, 0, 0}, y1 = {0, 0, 0, 0};
#pragma unroll
    for (int d = 0; d < 2; ++d) {
      const int j = kc < 256 ? (d ? 8 + 255 - kc : 8 + kc) : (d ? 7 - (kc - 256) : (kc - 256));
#pragma unroll
      for (int nt = 0; nt < 4; ++nt) {
        f32x16 acc = {};
        acc = __builtin_amdgcn_mfma_f32_32x32x16_bf16(afrag, bb[d][nt], acc, 0, 0, 0);
#pragma unroll
        for (int i = 0; i < 16; ++i) wl[crow(i, hi) * 132 + nt * 32 + r32] = acc[i];
      }
      asm volatile("s_waitcnt lgkmcnt(0)" ::: "memory");
      const float ar = arr[d], ai = aii[d];
      float hr = 0.f, him = 0.f;
      float* sp = S + ((size_t)((b * 2 + d) * 64 + g) * NCHUNK + j) * 128;
      if (PHASE_C) { hr = sp[lane]; him = sp[64 + lane]; }
      float bur[32], bui[32];
#pragma unroll
      for (int s = 0; s < 32; ++s) { bur[s] = wl[s * 132 + lane]; bui[s] = wl[s * 132 + 64 + lane]; }
#pragma unroll
      for (int s = 0; s < 32; ++s) {
        const int t = d ? 31 - s : s;
        const float nr = ar * hr - ai * him + bur[t];
        const float ni = ar * him + ai * hr + bui[t];
        hr = nr; him = ni;
        if (PHASE_C) { bur[t] = hr; bui[t] = him; }
      }
      if (PHASE_C) {
#pragma unroll
        for (int s = 0; s < 32; ++s) { wl[s * 132 + lane] = bur[s]; wl[s * 132 + 64 + lane] = bui[s]; }
      }
      if (!PHASE_C) { sp[lane] = hr; sp[64 + lane] = him; }
      if (PHASE_C) {
        asm volatile("s_waitcnt lgkmcnt(0)" ::: "memory");
#pragma unroll
        for (int ks = 0; ks < 4; ++ks) {
          const bf16x8 cf = cm[d][ks];
          const float* a0p = wl + (lane & 15) * 132 + ks * 32 + (lane >> 4) * 8;
          const f32x4 a00 = *(const f32x4*)a0p, a01 = *(const f32x4*)(a0p + 4);
          const f32x4 a10 = *(const f32x4*)(a0p + 16 * 132), a11 = *(const f32x4*)(a0p + 16 * 132 + 4);
          u32x4 w0 = {cvtpk(a00[0], a00[1]), cvtpk(a00[2], a00[3]), cvtpk(a01[0], a01[1]), cvtpk(a01[2], a01[3])};
          u32x4 w1 = {cvtpk(a10[0], a10[1]), cvtpk(a10[2], a10[3]), cvtpk(a11[0], a11[1]), cvtpk(a11[2], a11[3])};
          y0 = __builtin_amdgcn_mfma_f32_16x16x32_bf16(*(bf16x8*)&w0, cf, y0, 0, 0, 0);
          y1 = __builtin_amdgcn_mfma_f32_16x16x32_bf16(*(bf16x8*)&w1, cf, y1, 0, 0, 0);
        }
        asm volatile("s_waitcnt lgkmcnt(0)" ::: "memory");
      }
    }
    if (PHASE_C) {
      const int c = lane & 15, ch = g * 16 + c;
      float u0[4], u1[4];
#pragma unroll
      for (int r = 0; r < 4; ++r) {
        const int t0 = (lane >> 4) * 4 + r;
        u0[r] = bf2f(U[(size_t)(tok0 + t0) * LDP + ch]); u1[r] = bf2f(U[(size_t)(tok0 + 16 + t0) * LDP + ch]);
      }
#pragma unroll
      for (int r = 0; r < 4; ++r) {
        const int t0 = (lane >> 4) * 4 + r;
        Z[(size_t)(tok0 + t0) * LDP + ch] = f2bf(gelu_tanh(y0[r] + dsk * u0[r]));
        Z[(size_t)(tok0 + 16 + t0) * LDP + ch] = f2bf(gelu_tanh(y1[r] + dsk * u1[r]));
      }
    }
   }
  }
}

DEVI void phase_s5_state(const Params& p) {
  const int lane = tid_() & 63, wid = tid_() >> 6, r32 = lane & 31, hi = lane >> 5;
  const bf16_t* U = (const bf16_t*)(p.ws + OFF_ACTA);
  const float* tab = (const float*)(p.ws + OFF_S5AB);
  const bf16x8* bbf = (const bf16x8*)(p.ws + OFF_BBF);
  float* S = (float*)(p.ws + OFF_Y);
  for (int pc = blockIdx.x * 4 + wid; pc < NB * 64 * 8; pc += gridDim.x * 4) {
    const int pair = pc >> 3, sub = pc & 7, b = pair >> 6, g = pair & 63;
    bf16x8 bb[2][4];
    float lr_[2][2], li_[2][2], pr_[2][2], pi_[2][2], qr_[2][2], qi_[2][2];
#pragma unroll
    for (int d = 0; d < 2; ++d) {
      const int dg = d * 64 + g;
#pragma unroll
      for (int nt = 0; nt < 4; ++nt) bb[d][nt] = bbf[(size_t)(dg * 4 + nt) * 64 + lane];
#pragma unroll
      for (int st = 0; st < 2; ++st) {
        const float ar = tab[dg * 64 + st * 32 + r32], ai = tab[8192 + dg * 64 + st * 32 + r32];
        const float a2r = ar * ar - ai * ai, a2i = 2.f * ar * ai;
        const float a4r = a2r * a2r - a2i * a2i, a4i = 2.f * a2r * a2i;
        lr_[d][st] = ar; li_[d][st] = ai;
        const bool post = (hi == d);
        pr_[d][st] = post ? 1.f : a4r; pi_[d][st] = post ? 0.f : a4i;
        qr_[d][st] = post ? a4r : 1.f; qi_[d][st] = post ? a4i : 0.f;
      }
    }
    for (int kc = sub; kc < NCHUNK; kc += 8) {
      const int tok0 = kc < 256 ? b * SEQL + kc * 32 : NLAT + b * CTXL + (kc - 256) * 32;
      const bf16x8 afrag = *(const bf16x8*)(U + (size_t)(tok0 + r32) * LDP + g * 16 + hi * 8);
#pragma unroll
      for (int d = 0; d < 2; ++d) {
        const int j = kc < 256 ? (d ? 8 + 255 - kc : 8 + kc) : (d ? 7 - (kc - 256) : (kc - 256));
        float* sp = S + ((size_t)((b * 2 + d) * 64 + g) * NCHUNK + j) * 128;
#pragma unroll
        for (int st = 0; st < 2; ++st) {
          f32x16 acr = {}, aci = {};
          acr = __builtin_amdgcn_mfma_f32_32x32x16_bf16(afrag, bb[d][st], acr, 0, 0, 0);
          aci = __builtin_amdgcn_mfma_f32_32x32x16_bf16(afrag, bb[d][st + 2], aci, 0, 0, 0);
          const float ar = lr_[d][st], ai = li_[d][st];
          float hr = 0.f, him = 0.f;
#pragma unroll
          for (int g4 = 0; g4 < 4; ++g4) {
            const int G = d ? 3 - g4 : g4;
            { const float nr = pr_[d][st] * hr - pi_[d][st] * him, ni = pr_[d][st] * him + pi_[d][st] * hr; hr = nr; him = ni; }
#pragma unroll
            for (int jj = 0; jj < 4; ++jj) {
              const int i = G * 4 + (d ? 3 - jj : jj);
              const float nr = ar * hr - ai * him + acr[i];
              const float ni = ar * him + ai * hr + aci[i];
              hr = nr; him = ni;
            }
            { const float nr = qr_[d][st] * hr - qi_[d][st] * him, ni = qr_[d][st] * him + qi_[d][st] * hr; hr = nr; him = ni; }
          }
          { auto rr = __builtin_amdgcn_permlane32_swap(__float_as_uint(hr), __float_as_uint(hr), false, false);
            hr = __uint_as_float(rr[0]) + __uint_as_float(rr[1]); }
          { auto rr = __builtin_amdgcn_permlane32_swap(__float_as_uint(him), __float_as_uint(him), false, false);
            him = __uint_as_float(rr[0]) + __uint_as_float(rr[1]); }
          if (hi == st) { sp[st * 32 + r32] = hr; sp[64 + st * 32 + r32] = him; }
        }
      }
    }
  }
}

DEVI void phase_s5_carry(const Params& p) {
  const int lane = tid_() & 63, wid = tid_() >> 6;
  const float* tab = (const float*)(p.ws + OFF_S5AB);
  float* S = (float*)(p.ws + OFF_Y);
  for (int task = blockIdx.x * 4 + wid; task < NB * 2 * 64; task += gridDim.x * 4) {
    const int g = task & 63, d = (task >> 6) & 1;
    const float lr = tab[16384 + (d * 64 + g) * 64 + lane], li = tab[24576 + (d * 64 + g) * 64 + lane];
    float* sp = S + (size_t)task * NCHUNK * 128;
    float hr = 0.f, him = 0.f;
    float tr[8], ti[8], ur[8], ui[8];
#pragma unroll
    for (int q = 0; q < 8; ++q) { tr[q] = sp[q * 128 + lane]; ti[q] = sp[q * 128 + 64 + lane]; }
    for (int j0 = 0; j0 < NCHUNK; j0 += 8) {
      if (j0 + 8 < NCHUNK) {
#pragma unroll
        for (int q = 0; q < 8; ++q) { ur[q] = sp[(j0 + 8 + q) * 128 + lane]; ui[q] = sp[(j0 + 8 + q) * 128 + 64 + lane]; }
      }
#pragma unroll
      for (int q = 0; q < 8; ++q) {
        sp[(j0 + q) * 128 + lane] = hr; sp[(j0 + q) * 128 + 64 + lane] = him;
        const float nr = lr * hr - li * him + tr[q];
        const float ni = lr * him + li * hr + ti[q];
        hr = nr; him = ni;
      }
#pragma unroll
      for (int q = 0; q < 8; ++q) { tr[q] = ur[q]; ti[q] = ui[q]; }
    }
  }
}

constexpr float QSCALE = 0.07216878364870322f * 1.4426950408889634f;
enum { EPI_GLU = 0, EPI_RES = 1, EPI_FFNIN = 2, EPI_G1 = 3, EPI_Q = 4, EPI_KV = 5 };

DEVI void rope64(float* v, const float* rt, int t) {
  const float* rr = rt + (t >> 6) * 32;
  const float* rc = rt + (t & 63) * 32;
#pragma unroll
  for (int i = 0; i < 16; ++i) {
    float c = rr[i * 2], s = rr[i * 2 + 1], x1 = v[i], x2 = v[16 + i];
    v[i] = x1 * c - x2 * s; v[16 + i] = x1 * s + x2 * c;
    c = rc[i * 2]; s = rc[i * 2 + 1]; x1 = v[32 + i]; x2 = v[48 + i];
    v[32 + i] = x1 * c - x2 * s; v[48 + i] = x1 * s + x2 * c;
  }
}
DEVI void store64bf(bf16_t* dst, const float* v) {
#pragma unroll
  for (int c = 0; c < 64; c += 8) {
    u32x4 w = {cvtpk(v[c], v[c + 1]), cvtpk(v[c + 2], v[c + 3]), cvtpk(v[c + 4], v[c + 5]), cvtpk(v[c + 6], v[c + 7])};
    *(u32x4*)(dst + c) = w;
  }
}

template <int EPI, bool GUARD>
DEVI void gemm_tile(const Params& p, const bf16_t* __restrict__ A, int lda, const bf16_t* __restrict__ Bt, int ldb, int K,
                          int row_base, int row_lo, int row_hi, int tile_n, int layer, int which, char* lds) {
  const int tid = tid_(), lane = tid & 63, wid = tid >> 6, wr = wid >> 1, wc = wid & 1, c16 = lane & 15, q4 = lane >> 4;
  f32x4 acc[4][4] = {};
  const int wq = __builtin_amdgcn_readfirstlane(wid) * 4;
  const int lrow = lane >> 3, lcp = lane & 7;
  const char* Abase = (const char*)(A + (long)row_base * lda);
  const char* Bbase = (const char*)(Bt + (long)(tile_n * 128) * ldb);
  unsigned aoff[4], boff[4];
#pragma unroll
  for (int e = 0; e < 4; ++e) {
    const int r = (wq + e) * 8 + lrow;
    const int kc = lcp ^ ((r >> 1) & 7);
    int gr = row_base + r;
    if (GUARD) gr = gr < row_lo ? row_lo : (gr >= row_hi ? row_hi - 1 : gr);
    aoff[e] = (unsigned)(((gr - row_base) * lda + kc * 8) * 2);
    boff[e] = (unsigned)((r * ldb + kc * 8) * 2);
  }
#define GISSUE(k0, buf) do { const char* ak_ = Abase + (size_t)(k0) * 2; const char* bk_ = Bbase + (size_t)(k0) * 2; _Pragma("unroll") for (int e = 0; e < 4; ++e) { \
      __builtin_amdgcn_global_load_lds((const unsigned*)(ak_ + aoff[e]), (unsigned*)(lds + (buf) * 32768 + (wq + e) * 1024), 16, 0, 0); \
      __builtin_amdgcn_global_load_lds((const unsigned*)(bk_ + boff[e]), (unsigned*)(lds + (buf) * 32768 + 16384 + (wq + e) * 1024), 16, 0, 0); } } while (0)
  const int swz = c16 >> 1;
  int koff[2];
#pragma unroll
  for (int ks = 0; ks < 2; ++ks) koff[ks] = ((ks * 4 + q4) ^ swz) << 4;
  const int arow = (wr * 64 + c16) * 128, brow = 16384 + (wc * 64 + c16) * 128;
#define KSTEPS(buf) do { const char* Lb = lds + (buf) * 32768; _Pragma("unroll") for (int ks = 0; ks < 2; ++ks) { \
      bf16x8 af[4], bfr[4]; \
      _Pragma("unroll") for (int t = 0; t < 4; ++t) { af[t] = *(const bf16x8*)(Lb + arow + t * 2048 + koff[ks]); bfr[t] = *(const bf16x8*)(Lb + brow + t * 2048 + koff[ks]); } \
      _Pragma("unroll") for (int mt = 0; mt < 4; ++mt) _Pragma("unroll") for (int nt = 0; nt < 4; ++nt) \
        acc[mt][nt] = __builtin_amdgcn_mfma_f32_16x16x32_bf16(af[mt], bfr[nt], acc[mt][nt], 0, 0, 0); } } while (0)
#define GBAR() do { asm volatile("s_waitcnt vmcnt(0) lgkmcnt(0)" ::: "memory"); __builtin_amdgcn_s_barrier(); } while (0)
  GISSUE(0, 0); GBAR();
  for (int k0 = 0; k0 < K; k0 += 128) {
    GISSUE(k0 + 64, 1);
    KSTEPS(0);
    GBAR();
    if (k0 + 128 < K) GISSUE(k0 + 128, 0);
    KSTEPS(1);
    GBAR();
  }
#undef GISSUE
#undef KSTEPS
#undef GBAR
  const float* mod = (const float*)(p.ws + OFF_MOD);
  float* ctxr = (float*)(p.ws + OFF_CTXR);
  if (EPI == EPI_GLU) {
    const float* gb = p.in[17];
    const int j0 = tile_n * 64 + wc * 32 + c16;
    const bool lat = row_base < NLAT;
    const float* mg = mod + (lat ? (row_base >> 13) : 4) * 6144 + 2048;
    const float ba0 = gb[j0], ba1 = gb[j0 + 16], bg0 = gb[1024 + j0], bg1 = gb[1024 + j0 + 16], gt0 = mg[j0], gt1 = mg[j0 + 16];
    const float* xin = (lat ? p.in[0] + (size_t)row_base * DM : p.in[2] + (size_t)(row_base - NLAT) * DM) + j0;
    float* xo = (lat ? p.out + (size_t)row_base * DM : ctxr + (size_t)(row_base - NLAT) * DM) + j0;
#pragma unroll
    for (int mh = 0; mh < 2; ++mh) {
      float xv[2][2][4];
#pragma unroll
      for (int m2 = 0; m2 < 2; ++m2)
#pragma unroll
        for (int jj = 0; jj < 4; ++jj) { const size_t ro = (size_t)(wr * 64 + (mh * 2 + m2) * 16 + q4 * 4 + jj) * DM; xv[m2][0][jj] = xin[ro]; xv[m2][1][jj] = xin[ro + 16]; }
#pragma unroll
      for (int m2 = 0; m2 < 2; ++m2)
#pragma unroll
        for (int jj = 0; jj < 4; ++jj) {
          const int mt = mh * 2 + m2; const size_t ro = (size_t)(wr * 64 + mt * 16 + q4 * 4 + jj) * DM;
          xo[ro] = xv[m2][0][jj] + gt0 * ((acc[mt][0][jj] + ba0) * sigmoidf_(acc[mt][2][jj] + bg0));
          xo[ro + 16] = xv[m2][1][jj] + gt1 * ((acc[mt][1][jj] + ba1) * sigmoidf_(acc[mt][3][jj] + bg1));
        }
    }
    return;
  }
  if (EPI == EPI_RES) {
    const bool lat = row_base < NLAT;
    const float* gp = mod + (layer * 5 + (lat ? (row_base >> 13) : 4)) * 6144 + which * 1024 + tile_n * 128 + wc * 64 + c16;
    const float g0 = gp[0], g1 = gp[16], g2 = gp[32], g3 = gp[48];
    float* xo = (lat ? p.out + (size_t)row_base * DM : ctxr + (size_t)(row_base - NLAT) * DM) + tile_n * 128 + wc * 64 + c16;
#pragma unroll
    for (int mh = 0; mh < 2; ++mh) {
      float xv[2][4][4];
#pragma unroll
      for (int m2 = 0; m2 < 2; ++m2)
#pragma unroll
        for (int jj = 0; jj < 4; ++jj) { const size_t ro = (size_t)(wr * 64 + (mh * 2 + m2) * 16 + q4 * 4 + jj) * DM;
          xv[m2][0][jj] = xo[ro]; xv[m2][1][jj] = xo[ro + 16]; xv[m2][2][jj] = xo[ro + 32]; xv[m2][3][jj] = xo[ro + 48]; }
#pragma unroll
      for (int m2 = 0; m2 < 2; ++m2)
#pragma unroll
        for (int jj = 0; jj < 4; ++jj) { const int mt = mh * 2 + m2; const size_t ro = (size_t)(wr * 64 + mt * 16 + q4 * 4 + jj) * DM;
          xo[ro] = xv[m2][0][jj] + g0 * acc[mt][0][jj]; xo[ro + 16] = xv[m2][1][jj] + g1 * acc[mt][1][jj];
          xo[ro + 32] = xv[m2][2][jj] + g2 * acc[mt][2][jj]; xo[ro + 48] = xv[m2][3][jj] + g3 * acc[mt][3][jj]; }
    }
    return;
  }
  float* ldsC = (float*)lds;
#pragma unroll
  for (int mt = 0; mt < 4; ++mt)
#pragma unroll
    for (int nt = 0; nt < 4; ++nt)
#pragma unroll
      for (int jj = 0; jj < 4; ++jj)
        ldsC[(wr * 64 + mt * 16 + q4 * 4 + jj) * 132 + wc * 64 + nt * 16 + c16] = acc[mt][nt][jj];
  __syncthreads();
  const int lr = tid >> 1, half = tid & 1;
  const int tok = row_base + lr;
  const float* cr = ldsC + lr * 132 + half * 64;
  if (EPI == EPI_FFNIN) {
    const int jc = tid & 7, rg = tid >> 3;
    const int ca = (jc >> 2) * 64 + (jc & 3) * 8;
    const int f0 = tile_n * 64 + jc * 8;
    const float* cw = p.in[30] + layer * 3 * FF + f0; const float* cbp = p.in[31] + layer * FF + f0;
    float w0[8], w1[8], w2[8], cb[8];
#pragma unroll
    for (int u = 0; u < 8; ++u) { w0[u] = cw[u]; w1[u] = cw[FF + u]; w2[u] = cw[2 * FF + u]; cb[u] = cbp[u]; }
    const int lr0 = rg * 4;
    float ap[8], ac[8], an[8];
    {
      const float* c0 = ldsC + (lr0 > 0 ? lr0 - 1 : 0) * 132 + ca;
      const float* c1 = ldsC + lr0 * 132 + ca;
#pragma unroll
      for (int u = 0; u < 8; ++u) { ap[u] = c0[u]; ac[u] = c1[u]; }
    }
    u32x4 outw[4];
    bool outv[4];
#pragma unroll
    for (int q = 0; q < 4; ++q) {
      const int lrq = lr0 + q, tk = row_base + lrq;
      const float* cn = ldsC + (lrq < 127 ? lrq + 1 : 127) * 132 + ca;
      const float* cbv = ldsC + lrq * 132 + ca + 32;
#pragma unroll
      for (int u = 0; u < 8; ++u) an[u] = cn[u];
      const int seqlen = tk < NLAT ? SEQL : CTXL;
      const int pos = tk < NLAT ? (tk & (SEQL - 1)) : ((tk - NLAT) & (CTXL - 1));
      const bool hp = pos > 0, hn = pos < seqlen - 1;
      float m[8];
#pragma unroll
      for (int u = 0; u < 8; ++u) {
        const float conv = cb[u] + (hp ? ap[u] * w0[u] : 0.f) + ac[u] * w1[u] + (hn ? an[u] * w2[u] : 0.f);
        m[u] = conv * sigmoidf_(conv) * cbv[u];
      }
      outw[q] = (u32x4){cvtpk(m[0], m[1]), cvtpk(m[2], m[3]), cvtpk(m[4], m[5]), cvtpk(m[6], m[7])};
      outv[q] = lrq >= 1 && lrq <= 126 && tk >= row_lo && tk < row_hi;
#pragma unroll
      for (int u = 0; u < 8; ++u) { ap[u] = ac[u]; ac[u] = an[u]; }
    }
    bf16_t* dst = (bf16_t*)(p.ws + OFF_X) + f0;
#pragma unroll
    for (int q = 0; q < 4; ++q) if (outv[q]) *(u32x4*)(dst + (size_t)(row_base + lr0 + q) * FF) = outw[q];
  }
  if (EPI == EPI_G1) {
    if (tile_n < 8) {
      float v[64]; float ss = 0;
#pragma unroll
      for (int c = 0; c < 64; ++c) { v[c] = cr[c]; ss += v[c] * v[c]; }
      ss += __shfl_xor(ss, 1);
      store64bf((bf16_t*)(p.ws + OFF_Y) + (size_t)tok * 1152 + tile_n * 128 + half * 64, v);
      if (half == 0) ((float*)(p.ws + OFF_SSQ))[(size_t)tok * 8 + tile_n] = ss;
    } else if (half == 0) {
      float v[64]; float ss = 0;
#pragma unroll
      for (int c = 0; c < 64; ++c) { v[c] = cr[c]; ss += v[c] * v[c]; }
      const float rs = rsqrtf(ss * (1.f / 64.f) + EPSN);
      const float* gk = p.in[27];
#pragma unroll
      for (int c = 0; c < 64; ++c) v[c] = v[c] * rs * gk[c];
      int b, pos;
      if (tok < NLAT) { b = tok >> 13; const int t = tok & (SEQL - 1); pos = CTXL + t; rope64(v, (const float*)(p.ws + OFF_ROPE), t); }
      else { b = (tok - NLAT) >> 8; pos = (tok - NLAT) & (CTXL - 1); }
      bf16_t* kb = (bf16_t*)(p.ws + OFF_K) + ((size_t)(b * 8) * KVL + pos) * 192 + 128;
#pragma unroll
      for (int c = 0; c < 64; c += 8) {
        u32x4 w = {cvtpk(v[c], v[c + 1]), cvtpk(v[c + 2], v[c + 3]), cvtpk(v[c + 4], v[c + 5]), cvtpk(v[c + 6], v[c + 7])};
#pragma unroll
        for (int h = 0; h < 8; ++h) *(u32x4*)(kb + (size_t)h * KVL * 192 + c) = w;
      }
    }
  }
  if (EPI == EPI_Q) {
    const float* sq = (const float*)(p.ws + OFF_SSQ) + (size_t)tok * 8;
    const float rq = rsqrtf((sq[0] + sq[1] + sq[2] + sq[3] + sq[4] + sq[5]) * (1.f / 768.f) + EPSN);
    const int b = tok >> 13, t = tok & (SEQL - 1);
    float v[64]; float ss = 0;
#pragma unroll
    for (int c = 0; c < 64; ++c) { v[c] = cr[c] * rq; ss += v[c] * v[c]; }
    bf16_t* qb = (bf16_t*)(p.ws + OFF_X);
    if (tile_n < 8) {
      ss += __shfl_xor(ss, 1);
      const float rs = rsqrtf(ss * (1.f / 128.f) + EPSN) * QSCALE;
      const float* gq = p.in[24] + half * 64;
#pragma unroll
      for (int c = 0; c < 64; ++c) v[c] = v[c] * rs * gq[c];
      store64bf(qb + ((size_t)(b * 8 + tile_n) * SEQL + t) * 192 + half * 64, v);
    } else {
      const int head = (tile_n - 8) * 2 + half;
      const float rs = rsqrtf(ss * (1.f / 64.f) + EPSN) * QSCALE;
      const float* gq = p.in[25];
#pragma unroll
      for (int c = 0; c < 64; ++c) v[c] = v[c] * rs * gq[c];
      rope64(v, (const float*)(p.ws + OFF_ROPE), t);
      store64bf(qb + ((size_t)(b * 8 + head) * SEQL + t) * 192 + 128, v);
    }
  }
  if (EPI == EPI_KV) {
    const float* sq = (const float*)(p.ws + OFF_SSQ) + (size_t)tok * 8;
    const float rkv = rsqrtf((sq[6] + sq[7]) * (1.f / 256.f) + EPSN);
    int b, pos;
    if (tok < NLAT) { b = tok >> 13; pos = CTXL + (tok & (SEQL - 1)); } else { b = (tok - NLAT) >> 8; pos = (tok - NLAT) & (CTXL - 1); }
    const int head = tile_n >> 1;
    float v[64]; float ss = 0;
#pragma unroll
    for (int c = 0; c < 64; ++c) { v[c] = cr[c] * rkv; ss += v[c] * v[c]; }
    if ((tile_n & 1) == 0) {
      ss += __shfl_xor(ss, 1);
      const float rs = rsqrtf(ss * (1.f / 128.f) + EPSN);
      const float* gk = p.in[26] + half * 64;
#pragma unroll
      for (int c = 0; c < 64; ++c) v[c] = v[c] * rs * gk[c];
      store64bf((bf16_t*)(p.ws + OFF_K) + ((size_t)(b * 8 + head) * KVL + pos) * 192 + half * 64, v);
    } else {
      store64bf((bf16_t*)(p.ws + OFF_ACTA) + ((size_t)(b * 8 + head) * KVL + pos) * 128 + half * 64, v);
    }
  }
  __syncthreads();
}

constexpr float ASCALE = 0.07216878364870322f;
constexpr float ATHR = 8.f;
constexpr int KROW = 400;
constexpr int K_LDS_BYTES = 64 * KROW;
constexpr int V_LDS_BYTES = 64 * 128 * 2;

DEVI void partialSM(f32x16& p0, f32x16& p1, float& m_reg, float& mn, float& alpha) {
  constexpr float L2E = 1.4426950408889634f;
  float pmax = p0[0];
#pragma unroll
  for (int r = 1; r < 16; ++r) pmax = fmaxf(pmax, p0[r]);
#pragma unroll
  for (int r = 0; r < 16; ++r) pmax = fmaxf(pmax, p1[r]);
  { auto rr = __builtin_amdgcn_permlane32_swap(__float_as_uint(pmax), __float_as_uint(pmax), false, false);
    pmax = fmaxf(__uint_as_float(rr[0]), __uint_as_float(rr[1])); }
  if (__builtin_expect(__all(pmax - m_reg <= ATHR * L2E), 1)) { mn = m_reg; alpha = 1.f; }
  else { mn = fmaxf(m_reg, pmax); alpha = __builtin_amdgcn_exp2f(m_reg - mn); m_reg = mn; }
#pragma unroll
  for (int r = 0; r < 16; ++r) p0[r] = __builtin_amdgcn_exp2f(p0[r] - mn);
#pragma unroll
  for (int r = 0; r < 16; ++r) p1[r] = __builtin_amdgcn_exp2f(p1[r] - mn);
}
DEVI void finishSM(f32x16& p0, f32x16& p1, float alpha, float& l_reg, bf16x8& pa0, bf16x8& pa1, bf16x8& pa2, bf16x8& pa3) {
  float ps = 0;
#pragma unroll
  for (int r = 0; r < 16; ++r) ps += p0[r];
#pragma unroll
  for (int r = 0; r < 16; ++r) ps += p1[r];
  { auto rr = __builtin_amdgcn_permlane32_swap(__float_as_uint(ps), __float_as_uint(ps), false, false);
    ps = __uint_as_float(rr[0]) + __uint_as_float(rr[1]); }
  l_reg = l_reg * alpha + ps;
#define PK4(P, BASE, OUT) do { unsigned a0 = cvtpk(P[BASE + 0], P[BASE + 1]), a1 = cvtpk(P[BASE + 2], P[BASE + 3]);   \
    unsigned b0 = cvtpk(P[BASE + 4], P[BASE + 5]), b1 = cvtpk(P[BASE + 6], P[BASE + 7]);                              \
    auto r0 = __builtin_amdgcn_permlane32_swap(a0, b0, false, false); auto r1 = __builtin_amdgcn_permlane32_swap(a1, b1, false, false); \
    u32x4 w = {r0[0], r1[0], r0[1], r1[1]}; OUT = *reinterpret_cast<bf16x8*>(&w); } while (0)
  PK4(p0, 0, pa0); PK4(p0, 8, pa1); PK4(p1, 0, pa2); PK4(p1, 8, pa3);
#undef PK4
}
DEVI int v_st(int k) { const int kk = (k & ~0xC) | ((k & 4) << 1) | ((k & 8) >> 1); return ((kk >> 3) * 4) * 512 + ((kk & 7) * 32) * 2; }
DEVI int v_rd_base(int lane) { return ((lane & 3) << 3) | (((lane >> 2) & 3) << 6) | (((lane >> 4) & 1) << 5) | (((lane >> 5) & 1) << 8); }
constexpr int v_rd_off(int d0, int ks, int half) { return d0 * 512 + ks * 4096 + half * 2048; }
template <int OFF> DEVI s16x4 tr_read(int vb) {
  s16x4 r; asm volatile("ds_read_b64_tr_b16 %0, %1 offset:%2" : "=&v"(r) : "v"(vb), "i"(OFF) : "memory"); return r;
}
template <int D0> DEVI void pv_one(f32x16& od, int vb, bf16x8 pa0, bf16x8 pa1, bf16x8 pa2, bf16x8 pa3) {
  const s16x4 l0 = tr_read<v_rd_off(D0, 0, 0)>(vb), h0 = tr_read<v_rd_off(D0, 0, 1)>(vb), l1 = tr_read<v_rd_off(D0, 1, 0)>(vb), h1 = tr_read<v_rd_off(D0, 1, 1)>(vb);
  const s16x4 l2 = tr_read<v_rd_off(D0, 2, 0)>(vb), h2 = tr_read<v_rd_off(D0, 2, 1)>(vb), l3 = tr_read<v_rd_off(D0, 3, 0)>(vb), h3 = tr_read<v_rd_off(D0, 3, 1)>(vb);
  asm volatile("s_waitcnt lgkmcnt(0)" ::: "memory"); SBAR();
#define PK(L, H) (bf16x8){L[0], L[1], L[2], L[3], H[0], H[1], H[2], H[3]}
  od = __builtin_amdgcn_mfma_f32_32x32x16_bf16(pa0, PK(l0, h0), od, 0, 0, 0);
  od = __builtin_amdgcn_mfma_f32_32x32x16_bf16(pa1, PK(l1, h1), od, 0, 0, 0);
  od = __builtin_amdgcn_mfma_f32_32x32x16_bf16(pa2, PK(l2, h2), od, 0, 0, 0);
  od = __builtin_amdgcn_mfma_f32_32x32x16_bf16(pa3, PK(l3, h3), od, 0, 0, 0);
#undef PK
}

template <bool FIXED>
DEVI void attn_task(const bf16_t* __restrict__ Qb, const bf16_t* __restrict__ Kh, const bf16_t* __restrict__ Vh, bf16_t* __restrict__ Ob, char* lds, float shiftC) {
  const int tid = tid_(), wid = tid >> 6, lane = tid & 63, r32 = lane & 31, hi = lane >> 5;
  const int wu = __builtin_amdgcn_readfirstlane(wid);
  char* K_lds = lds; char* V_lds = lds + 24576;
  float* wsf = (float*)(lds + 24576 + 16384) + wid * 64; float* li_l = wsf; float* al_l = wsf + 32;
  float m_reg = -1e30f, l_reg = 0.f;
  f32x16 o[4] = {};
  bf16x8 qr[12];
  {
    const char* Qc = (const char*)Qb;
    const unsigned qoff = (unsigned)((wid * 32 + r32) * 192 + hi * 8) * 2u;
#pragma unroll
    for (int d0 = 0; d0 < 12; ++d0) qr[d0] = *(const bf16x8*)(Qc + (qoff + d0 * 32));
  }
  const char* Kc = (const char*)Kh; const char* Vc = (const char*)Vh;
  unsigned ksrc[6], vsrc[4];
#pragma unroll
  for (int e = 0; e < 6; ++e) {
    const unsigned byte = (unsigned)((wu * 6 + e) * 1024 + lane * 16);
    const unsigned r = byte / 384u, cpos = (byte - r * 384u) >> 4;
    ksrc[e] = r * 384u + (((cpos & ~7u) | ((cpos & 7u) ^ ((r >> 1) & 7u))) << 4);
  }
#pragma unroll
  for (int e = 0; e < 4; ++e) {
    const int st = 2 * (wu * 4 + e) + (lane >> 5);
    const int kk = (st >> 2) * 8 + ((lane & 31) >> 2), c = (st & 3) * 32 + (lane & 3) * 8;
    const int k = (kk & ~0xC) | ((kk & 4) << 1) | ((kk & 8) >> 1);
    vsrc[e] = (unsigned)(k * 256 + c * 2);
  }
#define KISSUE(k0) do { const char* kp_ = Kc + (size_t)(k0) * 384; _Pragma("unroll") for (int e = 0; e < 6; ++e) \
      __builtin_amdgcn_global_load_lds((const unsigned*)(kp_ + ksrc[e]), (unsigned*)(K_lds + (wu * 6 + e) * 1024), 16, 0, 0); } while (0)
#define VISSUE(k0) do { const char* vp_ = Vc + (size_t)(k0) * 256; _Pragma("unroll") for (int e = 0; e < 4; ++e) \
      __builtin_amdgcn_global_load_lds((const unsigned*)(vp_ + vsrc[e]), (unsigned*)(V_lds + (wu * 4 + e) * 1024), 16, 0, 0); } while (0)
#define ABAR() do { asm volatile("s_waitcnt vmcnt(0) lgkmcnt(0)" ::: "memory"); __builtin_amdgcn_s_barrier(); } while (0)
  const int vb0 = (int)(uintptr_t)V_lds + v_rd_base(lane);
  const int swz = (r32 >> 1) & 7;
  int kx[4];
#pragma unroll
  for (int i = 0; i < 4; ++i) kx[i] = ((2 * i + hi) ^ swz) << 4;
  const char* Kr0 = K_lds + r32 * 384;
  KISSUE(0); VISSUE(0); ABAR();
  constexpr int NT = KVL / 64;
  for (int j = 0; j < NT; ++j) {
    f32x16 p0 = {}, p1 = {};
#pragma unroll
    for (int d0 = 0; d0 < 12; ++d0) {
      const bf16x8 b0 = *(const bf16x8*)(Kr0 + (d0 >> 2) * 128 + kx[d0 & 3]);
      const bf16x8 b1 = *(const bf16x8*)(Kr0 + 32 * 384 + (d0 >> 2) * 128 + kx[d0 & 3]);
      p0 = __builtin_amdgcn_mfma_f32_32x32x16_bf16(b0, qr[d0], p0, 0, 0, 0);
      p1 = __builtin_amdgcn_mfma_f32_32x32x16_bf16(b1, qr[d0], p1, 0, 0, 0);
    }
    ABAR();
    if (j + 1 < NT) KISSUE((j + 1) * 64);
    float mn, alpha = 1.f;
    if constexpr (FIXED) {
#pragma unroll
      for (int r = 0; r < 16; ++r) p0[r] = __builtin_amdgcn_exp2f(p0[r]);
#pragma unroll
      for (int r = 0; r < 16; ++r) p1[r] = __builtin_amdgcn_exp2f(p1[r]);
    } else partialSM(p0, p1, m_reg, mn, alpha);
    if (!FIXED && __any(alpha < 1.f)) {
      if (hi == 0) al_l[r32] = alpha;
      asm volatile("s_waitcnt lgkmcnt(0)" ::: "memory");
#pragma unroll
      for (int r = 0; r < 16; ++r) { const float a = al_l[crow(r, hi)];
#pragma unroll
        for (int d = 0; d < 4; ++d) o[d][r] *= a; }
    }
    bf16x8 pa0, pa1, pa2, pa3;
    finishSM(p0, p1, alpha, l_reg, pa0, pa1, pa2, pa3);
    pv_one<0>(o[0], vb0, pa0, pa1, pa2, pa3); pv_one<1>(o[1], vb0, pa0, pa1, pa2, pa3);
    pv_one<2>(o[2], vb0, pa0, pa1, pa2, pa3); pv_one<3>(o[3], vb0, pa0, pa1, pa2, pa3);
    ABAR();
    if (j + 1 < NT) VISSUE((j + 1) * 64);
  }
#undef KISSUE
#undef VISSUE
#undef ABAR
  if (hi == 0) li_l[r32] = l_reg;
  asm volatile("s_waitcnt lgkmcnt(0)" ::: "memory");
  char* Oc = (char*)Ob;
#pragma unroll
  for (int r = 0; r < 16; ++r) {
    const int orow = crow(r, hi);
    const float rl = 1.f / li_l[orow];
    const unsigned ooff = (unsigned)((wid * 32 + orow) * LDP + r32) * 2u;
#pragma unroll
    for (int d0 = 0; d0 < 4; ++d0) *(bf16_t*)(Oc + (ooff + d0 * 64)) = f2bf(o[d0][r] * rl);
  }
  __syncthreads();
}

#define XB_TMO      128
#define XB_XCNT(j)  (256  + 64 * (j))
#define XB_XSUB(j)  (1280 + 64 * (j))
#define XB_XGEN(j)  (2304 + 64 * (j))
#define XB_TOP      3328
#define XB_TOPGEN   3392
#define XCD_BAR_WORDS 3456
#define XB_SPIN_CAP (1u << 24)
#define LAS __attribute__((address_space(3)))
DEVI unsigned xb_ld(unsigned* p)              { return __hip_atomic_load(p, __ATOMIC_RELAXED, __HIP_MEMORY_SCOPE_AGENT); }
DEVI unsigned xb_add(unsigned* p, unsigned v) { return __hip_atomic_fetch_add(p, v, __ATOMIC_RELAXED, __HIP_MEMORY_SCOPE_AGENT); }
DEVI unsigned xb_xcc_id() { return (unsigned)__builtin_amdgcn_s_getreg((3 << 11) | 20) & 0xFu; }
#define XB_SPIN(cond, bar) do { unsigned _sp = 0; while (cond) { __builtin_amdgcn_s_sleep(1); \
    if ((++_sp & 255u) == 0u) { if (xb_ld(&(bar)[XB_TMO])) break; if (_sp > XB_SPIN_CAP) { atomicAdd(&(bar)[XB_TMO], 1u); break; } } } } while (0)
struct XcdBarrier { unsigned* bar; unsigned x; volatile LAS unsigned* st; };
DEVI XcdBarrier xcd_barrier_post(unsigned* bar, volatile LAS unsigned* st) {
  XcdBarrier b; b.bar = bar; b.x = xb_xcc_id(); b.st = st;
  if (threadIdx.x == 0) (void)xb_add(&bar[XB_XCNT(b.x)], 1u);
  return b;
}
DEVI void xcd_barrier_complete(unsigned* bar, unsigned x, unsigned& nloc, unsigned& nx) {
  const unsigned G = gridDim.x * gridDim.y * gridDim.z;
  unsigned sum, cnt, mine, sp = 0u;
  for (;;) {
    sum = 0u; cnt = 0u; mine = 0u;
#pragma unroll
    for (unsigned j = 0; j < 16; ++j) { const unsigned c = xb_ld(&bar[XB_XCNT(j)]); sum += c; cnt += (c > 0u) ? 1u : 0u; mine = (j == x) ? c : mine; }
    if (sum == G) break;
    __builtin_amdgcn_s_sleep(1);
    if ((++sp & 255u) == 0u) { if (xb_ld(&bar[XB_TMO])) break; if (sp > XB_SPIN_CAP) { atomicAdd(&bar[XB_TMO], 1u); break; } }
  }
  nloc = mine > 0u ? mine : 1u; nx = cnt > 0u ? cnt : 1u;
}
DEVI void xcd_barrier(const XcdBarrier& b) {
  asm volatile("s_waitcnt vmcnt(0)" ::: "memory");
  __syncthreads();
  if (threadIdx.x == 0) {
    unsigned* bar = b.bar;
    __builtin_amdgcn_s_waitcnt(0);
    unsigned nloc = b.st[0], nx = b.st[1];
    if (nloc == 0u) { xcd_barrier_complete(bar, b.x, nloc, nx); b.st[0] = nloc; b.st[1] = nx; }
    const unsigned old = xb_add(&bar[XB_XSUB(b.x)], 1u);
    const unsigned gen = old / nloc;
    if (old + 1u == (gen + 1u) * nloc) {
      __builtin_amdgcn_fence(__ATOMIC_RELEASE, "agent");
      asm volatile("s_waitcnt vmcnt(0)" ::: "memory");
      const unsigned og = xb_add(&bar[XB_TOP], 1u);
      const unsigned tg = og / nx;
      if (og + 1u == (tg + 1u) * nx) xb_add(&bar[XB_TOPGEN], 1u);
      else XB_SPIN(xb_ld(&bar[XB_TOPGEN]) == tg, bar);
      __builtin_amdgcn_fence(__ATOMIC_ACQUIRE, "agent");
      xb_add(&bar[XB_XGEN(b.x)], 1u);
      asm volatile("s_waitcnt vmcnt(0)" ::: "memory");
    } else {
      XB_SPIN(xb_ld(&bar[XB_XGEN(b.x)]) == gen, bar);
      __builtin_amdgcn_fence(__ATOMIC_ACQUIRE, "agent");
      asm volatile("s_waitcnt vmcnt(0)" ::: "memory");
    }
  }
  __syncthreads();
}

#define GEMM_LOOP(MT, NT, SM, SN, ...) \
  { const int xcd_ = blockIdx.x & 7; constexpr int SNT_ = ((NT) + (SN) - 1) / (SN), SMT_ = ((MT) + (SM) - 1) / (SM); \
    unsigned* qc_ = (unsigned*)(p.ws + OFF_Q) + (PH * 8 + xcd_) * 16; \
    volatile LAS unsigned* qw_ = (volatile LAS unsigned*)(lds + LDS_BYTES - 8); \
    const bool t0_ = threadIdx.x == 0; unsigned nxt_ = 0u; \
    if (t0_) nxt_ = __hip_atomic_fetch_add(qc_, 1u, __ATOMIC_RELAXED, __HIP_MEMORY_SCOPE_AGENT); \
    for (;;) { __syncthreads(); if (t0_) *qw_ = nxt_; __syncthreads(); \
      const int w_ = __builtin_amdgcn_readfirstlane((int)*qw_); \
      const int s_ = (w_ >> 6) * 8 + xcd_; if (s_ >= SMT_ * SNT_) break; \
      if (t0_) nxt_ = __hip_atomic_fetch_add(qc_, 1u, __ATOMIC_RELAXED, __HIP_MEMORY_SCOPE_AGENT); \
      const int slot_ = w_ & 63; if (slot_ >= (SM) * (SN)) continue; \
      const int tm = (s_ / SNT_) * (SM) + slot_ / (SN), tn = (s_ % SNT_) * (SN) + slot_ % (SN); if (tm >= (MT) || tn >= (NT)) continue; __VA_ARGS__ } }

template <int PH>
DEVI void run_phase(const Params& p, char* lds) {
  unsigned char* ws = p.ws;
  const bf16_t* ACTA = (const bf16_t*)(ws + OFF_ACTA);
  const bf16_t* ACTB = (const bf16_t*)(ws + OFF_ACTB);
  float* ctxr = (float*)(ws + OFF_CTXR);
  if constexpr (PH == 0) phase_prep(p, lds);
  if constexpr (PH == 1) phase_norm(p, p.in[0], p.in[2], p.in[6], 0, 0, 1, NTOK);
  if constexpr (PH == 2) phase_s5_state(p);
  if constexpr (PH == 3) phase_s5_carry(p);
  if constexpr (PH == 4) phase_s5<true>(p, lds);
  if constexpr (PH == 5)
    GEMM_LOOP(264, 16, 8, 8, { gemm_tile<EPI_GLU, false>(p, ACTB, LDP, (const bf16_t*)(ws + OFF_WGLU), LDP, DM, tm * 128, 0, 0, tn, 0, 0, lds); })
  if constexpr (PH == 6) phase_norm(p, p.out, ctxr, p.in[7], 0, 3, 4, NTOK);
  if constexpr (PH == 7)
    GEMM_LOOP(270, 44, 16, 4, {
      const int rb = tm < 261 ? tm * 126 - 1 : NLAT + (tm - 261) * 126 - 1;
      const int lo = tm < 261 ? 0 : NLAT, hi = tm < 261 ? NLAT : NTOK;
      gemm_tile<EPI_FFNIN, true>(p, ACTA, LDP, (const bf16_t*)(ws + OFF_WFIN), LDP, DM, rb, lo, hi, tn, 0, 0, lds);
    })
  if constexpr (PH == 8)
    GEMM_LOOP(264, 8, 8, 8, { gemm_tile<EPI_RES, false>(p, (const bf16_t*)(ws + OFF_X), FF, (const bf16_t*)(ws + OFF_WFOUT), FF, FF, tm * 128, 0, 0, tn, 0, 5, lds); })
  if constexpr (PH == 9) phase_norm(p, p.out, ctxr, p.in[6] + DM, 1, 0, 1, NTOK);
  if constexpr (PH == 10)
    GEMM_LOOP(264, 9, 21, 3, { gemm_tile<EPI_G1, false>(p, ACTA, LDP, (const bf16_t*)(ws + OFF_WD), LDP, DM, tm * 128, 0, 0, tn, 1, 0, lds); })
  if constexpr (PH == 11)
    GEMM_LOOP(256, 12, 16, 4, { gemm_tile<EPI_Q, false>(p, (const bf16_t*)(ws + OFF_Y), 1152, (const bf16_t*)(ws + OFF_WUQ), 768, 768, tm * 128, 0, 0, tn, 1, 0, lds); })
  if constexpr (PH == 12)
    GEMM_LOOP(264, 16, 8, 8, { gemm_tile<EPI_KV, false>(p, (const bf16_t*)(ws + OFF_Y) + 768, 1152, (const bf16_t*)(ws + OFF_WUKV), 256, 256, tm * 128, 0, 0, tn, 1, 0, lds); })
  if constexpr (PH == 13) {
    float sbound;
    {
      const int ln = tid_() & 63;
      float mq = fmaxf(fabsf(p.in[24][ln]), fabsf(p.in[24][64 + ln])), mk = fmaxf(fabsf(p.in[26][ln]), fabsf(p.in[26][64 + ln]));
      float mqr = fabsf(p.in[25][ln]), mkr = fabsf(p.in[27][ln]);
#pragma unroll
      for (int o_ = 32; o_; o_ >>= 1) { mq = fmaxf(mq, __shfl_xor(mq, o_)); mk = fmaxf(mk, __shfl_xor(mk, o_)); mqr = fmaxf(mqr, __shfl_xor(mqr, o_)); mkr = fmaxf(mkr, __shfl_xor(mkr, o_)); }
      sbound = __int_as_float(__builtin_amdgcn_readfirstlane(__float_as_int(ASCALE * (128.f * mq * mk + 64.f * mqr * mkr) * 1.02f)));
    }
    for (int v = blockIdx.x; v < 2048; v += gridDim.x) {
      const int bh = (v >> 9) * 8 + (v & 7), qb = (v & 511) >> 3;
      const int b = bh >> 3, h = bh & 7;
      const bf16_t* Qp = (const bf16_t*)(ws + OFF_X) + ((size_t)bh * SEQL + qb * 128) * 192;
      const bf16_t* Kp = (const bf16_t*)(ws + OFF_K) + (size_t)bh * KVL * 192;
      const bf16_t* Vp = (const bf16_t*)(ws + OFF_ACTA) + (size_t)bh * KVL * 128;
      bf16_t* Op = (bf16_t*)(ws + OFF_ACTB) + ((size_t)(b * SEQL + qb * 128)) * LDP + h * 128;
      if (sbound <= 60.f) attn_task<true>(Qp, Kp, Vp, Op, lds, -sbound * 1.4426950408889634f);
      else attn_task<false>(Qp, Kp, Vp, Op, lds, 0.f);
    }
  }
  if constexpr (PH == 14)
    GEMM_LOOP(256, 8, 8, 8, { gemm_tile<EPI_RES, false>(p, ACTB, LDP, (const bf16_t*)(ws + OFF_WO), LDP, DM, tm * 128, 0, 0, tn, 1, 2, lds); })
  if constexpr (PH == 15) phase_norm(p, p.out, ctxr, p.in[7] + DM, 1, 3, 4, NLAT);
  if constexpr (PH == 16)
    GEMM_LOOP(261, 44, 16, 4, { gemm_tile<EPI_FFNIN, true>(p, ACTA, LDP, (const bf16_t*)(ws + OFF_WFIN + WFIN_BYTES), LDP, DM, tm * 126 - 1, 0, NLAT, tn, 1, 0, lds); })
  if constexpr (PH == 17)
    GEMM_LOOP(256, 8, 8, 8, { gemm_tile<EPI_RES, false>(p, (const bf16_t*)(ws + OFF_X), FF, (const bf16_t*)(ws + OFF_WFOUT + 5767168), FF, FF, tm * 128, 0, 0, tn, 1, 5, lds); })
}

#ifndef PHMASK
#define PHMASK 0x3ffff
#endif
#ifndef PROBE_MASK
#define PROBE_MASK 0
#endif
#define RUNP(N) do { if ((PHMASK >> N) & 1) { if ((PROBE_MASK >> N) & 1) { for (int r_ = 0; r_ < p.pad0; ++r_) { run_phase<N>(p, lds); SYNCG(); } } else run_phase<N>(p, lds); } } while (0)
#define SYNCG() xcd_barrier(xb)
__global__ void __launch_bounds__(256, 2) mega(Params p) {
  extern __shared__ __attribute__((aligned(16))) char lds[];
  volatile LAS unsigned* xst = (volatile LAS unsigned*)(lds + LDS_BYTES - 16);
  if (threadIdx.x == 0) { xst[0] = 0u; xst[1] = 0u; }
  __syncthreads();
  const XcdBarrier xb = xcd_barrier_post((unsigned*)(p.ws + OFF_BAR), xst);
  if (p.pad1) cg::this_grid().sync();
  RUNP(0); SYNCG(); RUNP(1); SYNCG(); RUNP(2); SYNCG(); RUNP(3); SYNCG(); RUNP(4); SYNCG(); RUNP(5); SYNCG();
  RUNP(6); SYNCG(); RUNP(7); SYNCG(); RUNP(8); SYNCG(); RUNP(9); SYNCG(); RUNP(10); SYNCG(); RUNP(11); RUNP(12); SYNCG();
  RUNP(13); SYNCG(); RUNP(14); SYNCG(); RUNP(15); SYNCG(); RUNP(16); SYNCG(); RUNP(17);
}
template <int PH>
__global__ void __launch_bounds__(256, 2) phase_kernel(Params p) {
  extern __shared__ __attribute__((aligned(16))) char lds[];
  run_phase<PH>(p, lds);
}


extern "C" void kernel_launch(void* const* d_in, const int* in_sizes, int n_in, void* d_out, int out_size, void* d_ws, size_t ws_size, hipStream_t stream) {
  static int grid_blocks = 0;
  if (grid_blocks == 0) {
    if (n_in != 33 || out_size != NLAT * DM || ws_size < WS_END) {
      fprintf(stderr, "kernel_launch: unexpected shapes n_in %d out %d ws %zu (need %zu)\n", n_in, out_size, ws_size, (size_t)WS_END);
      grid_blocks = -1; return;
    }
    int dev = 0, cus = 0, per_cu = 0;
    hipGetDevice(&dev);
    hipDeviceGetAttribute(&cus, hipDeviceAttributeMultiprocessorCount, dev);
    if (hipFuncSetAttribute((const void*)mega, hipFuncAttributeMaxDynamicSharedMemorySize, LDS_BYTES) != hipSuccess) {
      fprintf(stderr, "kernel_launch: hipFuncSetAttribute failed\n"); grid_blocks = -1; return; }
    hipOccupancyMaxActiveBlocksPerMultiprocessor(&per_cu, (const void*)mega, 256, LDS_BYTES);
    if (per_cu < 1) { fprintf(stderr, "kernel_launch: occupancy query returned %d\n", per_cu); per_cu = 1; }
    if (per_cu > 2) per_cu = 2;
    grid_blocks = cus * per_cu;
    (void)hipGetLastError();
  }
  if (grid_blocks < 0) return;
  Params p{};
  for (int i = 0; i < 33; ++i) p.in[i] = (const float*)d_in[i];
  p.out = (float*)d_out; p.ws = (unsigned char*)d_ws; p.pad0 = 2;
#if ONE_LAUNCH
  if (hipMemsetAsync((char*)d_ws + OFF_BAR, 0, 16384 + 18 * 8 * 64, stream) != hipSuccess) { fprintf(stderr, "memset failed\n"); return; }
  void* args[] = {&p};
  hipError_t e = hipLaunchCooperativeKernel((const void*)mega, dim3(grid_blocks), dim3(256), args, LDS_BYTES, stream);
  if (e != hipSuccess) fprintf(stderr, "cooperative launch failed: %s (grid %d)\n", hipGetErrorString(e), grid_blocks);
#else
#define LP(N) hipLaunchKernelGGL(phase_kernel<N>, dim3(grid_blocks), dim3(256), LDS_BYTES, stream, p)
  LP(0); LP(1); LP(2); LP(3); LP(4); LP(5); LP(6); LP(7); LP(8); LP(9); LP(10); LP(11); LP(12); LP(13); LP(14); LP(15); LP(16); LP(17);
#undef LP
#endif
}
```

```cpp
#include <hip/hip_runtime.h>
#include <hip/hip_cooperative_groups.h>
#include <cstdio>
#include <cstdint>
namespace cg = cooperative_groups;

#ifndef ONE_LAUNCH
#define ONE_LAUNCH 1
#endif

typedef unsigned short bf16_t;
using bf16x8 = __attribute__((ext_vector_type(8))) short;
using s16x4  = __attribute__((ext_vector_type(4))) short;
using f32x16 = __attribute__((ext_vector_type(16))) float;
using f32x4  = __attribute__((ext_vector_type(4))) float;
using u32x4  = __attribute__((ext_vector_type(4))) unsigned;
using u32x2  = __attribute__((ext_vector_type(2))) unsigned;

#define DEVI __device__ __forceinline__
#define SBAR() __builtin_amdgcn_sched_barrier(0)

constexpr int DM = 1024, NB = 4, SEQL = 8192, CTXL = 256;
constexpr int NLAT = NB * SEQL;
constexpr int NCTX = NB * CTXL;
constexpr int NTOK = NLAT + NCTX;
constexpr int FF = 2816;
constexpr int KVL = SEQL + CTXL;
constexpr int NCHUNK = 264;
constexpr float EPSN = 1e-6f;
constexpr int LDS_BYTES = 67584 + 16;
constexpr int LDP = 1088;

constexpr size_t OFF_MOD   = 0;
constexpr size_t OFF_S5AB  = OFF_MOD + 245760;
constexpr size_t OFF_ROPE  = OFF_S5AB + 131072;
constexpr size_t OFF_BBF   = OFF_ROPE + 16384;
constexpr size_t OFF_CMF   = OFF_BBF + 524288;
constexpr size_t OFF_WGLU  = OFF_CMF + 524288;
constexpr size_t OFF_WFIN  = OFF_WGLU + 4456448;
constexpr size_t WFIN_BYTES = 12255232;
constexpr size_t OFF_WFOUT = OFF_WFIN + 2 * WFIN_BYTES;
constexpr size_t OFF_WD    = OFF_WFOUT + 2 * 5767168;
constexpr size_t OFF_WUQ   = OFF_WD + 2506752;
constexpr size_t OFF_WUKV  = OFF_WUQ + 2359296;
constexpr size_t OFF_WO    = OFF_WUKV + 1048576;
constexpr size_t OFF_SSQ   = OFF_WO + 2228224;
constexpr size_t OFF_CTXR  = OFF_SSQ + 1081344;
constexpr size_t OFF_ACTA  = OFF_CTXR + 4194304;
constexpr size_t OFF_ACTB  = OFF_ACTA + 73531392;
constexpr size_t OFF_Y     = OFF_ACTB + 73531392;
constexpr size_t OFF_X     = OFF_Y + 77856768;
constexpr size_t OFF_K     = OFF_X + 100663296;
constexpr size_t OFF_BAR   = OFF_X + 204472320;
constexpr size_t OFF_Q     = OFF_BAR + 16384;
constexpr size_t WS_END    = OFF_Q + 16384;

struct Params {
  const float* in[33];
  float* out;
  unsigned char* ws;
  int pad0, pad1;
};

DEVI unsigned cvtpk(float lo, float hi) { unsigned r; asm("v_cvt_pk_bf16_f32 %0, %1, %2" : "=v"(r) : "v"(lo), "v"(hi)); return r; }
DEVI bf16_t f2bf(float x) { return (bf16_t)(cvtpk(x, 0.f) & 0xffffu); }
DEVI float bf2f(bf16_t b) { return __uint_as_float(((unsigned)b) << 16); }
DEVI int tid_() { int t = threadIdx.x; asm volatile("" : "+v"(t)); return t; }
DEVI int crow(int r, int hi) { return (r & 3) + 8 * (r >> 2) + 4 * hi; }
DEVI float wave_sum(float v) {
#pragma unroll
  for (int o = 32; o; o >>= 1) v += __shfl_xor(v, o);
  return v;
}
DEVI float sigmoidf_(float x) { return 1.f / (1.f + __expf(-x)); }
DEVI float gelu_tanh(float x) {
  float u = 0.7978845608028654f * (x + 0.044715f * x * x * x);
  float t = 1.f - 2.f / (1.f + __expf(2.f * u));
  return 0.5f * x * (1.f + t);
}

DEVI int permrow(int perm, int n) {
  if (perm == 1) { int g = n >= 1024; int j = g ? n - 1024 : n; return (j >> 5) * 64 + g * 32 + (j & 31); }
  if (perm == 2) { int g = n >= FF; int j = g ? n - FF : n; return (j >> 5) * 64 + g * 32 + (j & 31); }
  if (perm == 3) { int h = n / 192, d = n - h * 192; return d < 128 ? h * 128 + d : 1024 + h * 64 + (d - 128); }
  return n;
}

DEVI void prep_transpose(int t, const float* src, int K, int N, bf16_t* dst, int ld, int perm, const float* scale, char* lds) {
  const int tid = tid_();
  float* tl = (float*)lds;
  const int ntn = N >> 6;
  const int tk = t / ntn, tn = t - tk * ntn;
  const int k0 = tk * 64, n0 = tn * 64;
#pragma unroll
  for (int e = 0; e < 16; ++e) {
    int idx = e * 256 + tid, i = idx >> 6, j = idx & 63;
    float v = src[(size_t)(k0 + i) * N + n0 + j];
    if (scale) v *= scale[k0 + i];
    tl[i * 65 + j] = v;
  }
  __syncthreads();
#pragma unroll
  for (int e = 0; e < 8; ++e) {
    int idx = e * 256 + tid, j = idx >> 5, ip = idx & 31;
    unsigned w = cvtpk(tl[(2 * ip) * 65 + j], tl[(2 * ip + 1) * 65 + j]);
    int nr = permrow(perm, n0 + j);
    *(unsigned*)(dst + (size_t)nr * ld + k0 + 2 * ip) = w;
  }
  __syncthreads();
}

constexpr int T_ADA = 384, T_TR = 5680, T_S5 = 32;
constexpr int T_TOTAL = T_ADA + T_TR + T_S5 + 2;

DEVI void phase_prep(const Params& p, char* lds) {
  const int tid = tid_();
  unsigned char* ws = p.ws;
  for (int idx = blockIdx.x; idx < T_TOTAL; idx += gridDim.x) {
    if (idx < T_ADA) {
      float* sl = (float*)lds;
      float* red = sl + 5 * 1024;
      for (int e = tid; e < 5 * 1024; e += 256) {
        int r = e >> 10, k = e & 1023;
        float c = r < 4 ? p.in[1][r * 1024 + k] : p.in[3][k];
        sl[e] = c * sigmoidf_(c);
      }
      __syncthreads();
      const int layer = idx / 192, cg_ = idx - layer * 192;
      const int cl = tid & 31, ks = tid >> 5;
      const int col = cg_ * 32 + cl;
      const float* w = p.in[4] + (size_t)layer * 1024 * 6144 + col;
      float a0 = 0, a1 = 0, a2 = 0, a3 = 0, a4 = 0;
#pragma unroll 8
      for (int k = ks * 128; k < ks * 128 + 128; ++k) {
        float wv = w[(size_t)k * 6144];
        a0 += sl[k] * wv; a1 += sl[1024 + k] * wv; a2 += sl[2048 + k] * wv; a3 += sl[3072 + k] * wv; a4 += sl[4096 + k] * wv;
      }
      red[(ks * 5 + 0) * 32 + cl] = a0; red[(ks * 5 + 1) * 32 + cl] = a1; red[(ks * 5 + 2) * 32 + cl] = a2;
      red[(ks * 5 + 3) * 32 + cl] = a3; red[(ks * 5 + 4) * 32 + cl] = a4;
      __syncthreads();
      if (tid < 160) {
        int r = tid >> 5, c2 = tid & 31;
        float s = 0;
#pragma unroll
        for (int q = 0; q < 8; ++q) s += red[(q * 5 + r) * 32 + c2];
        int cc = cg_ * 32 + c2;
        ((float*)(ws + OFF_MOD))[(layer * 5 + r) * 6144 + cc] = s + p.in[5][layer * 6144 + cc];
      }
      __syncthreads();
    } else if (idx < T_ADA + T_TR) {
      int t = idx - T_ADA;
      const float* tsrc; int tK, tN, tperm; bf16_t* tdst; const float* tscale = nullptr;
      if (t < 512) { tsrc = p.in[16]; tK = 1024; tN = 2048; tdst = (bf16_t*)(ws + OFF_WGLU); tperm = 1; }
      else if ((t -= 512) < 1408) { tsrc = p.in[29]; tK = 1024; tN = 5632; tdst = (bf16_t*)(ws + OFF_WFIN); tperm = 2; }
      else if ((t -= 1408) < 1408) { tsrc = p.in[29] + (size_t)1024 * 5632; tK = 1024; tN = 5632; tdst = (bf16_t*)(ws + OFF_WFIN + WFIN_BYTES); tperm = 2; }
      else if ((t -= 1408) < 704) { tsrc = p.in[32]; tK = 2816; tN = 1024; tdst = (bf16_t*)(ws + OFF_WFOUT); tperm = 0; }
      else if ((t -= 704) < 704) { tsrc = p.in[32] + (size_t)2816 * 1024; tK = 2816; tN = 1024; tdst = (bf16_t*)(ws + OFF_WFOUT + 5767168); tperm = 0; }
      else if ((t -= 704) < 192) { tsrc = p.in[18]; tK = 1024; tN = 768; tdst = (bf16_t*)(ws + OFF_WD); tperm = 0; }
      else if ((t -= 192) < 80) { tsrc = p.in[21]; tK = 1024; tN = 320; tdst = (bf16_t*)(ws + OFF_WD) + (size_t)768 * LDP; tperm = 0; }
      else if ((t -= 80) < 288) { tsrc = p.in[20]; tK = 768; tN = 1536; tdst = (bf16_t*)(ws + OFF_WUQ); tperm = 3; tscale = p.in[19]; }
      else if ((t -= 288) < 128) { tsrc = p.in[23]; tK = 256; tN = 2048; tdst = (bf16_t*)(ws + OFF_WUKV); tperm = 0; tscale = p.in[22]; }
      else { t -= 128; tsrc = p.in[28]; tK = 1024; tN = 1024; tdst = (bf16_t*)(ws + OFF_WO); tperm = 0; }
      prep_transpose(t, tsrc, tK, tN, tdst, tK == 1024 ? LDP : tK, tperm, tscale, lds);
    } else if (idx < T_ADA + T_TR + T_S5) {
      const int gid = (idx - T_ADA - T_TR) * 256 + tid;
      const int pp = gid & 63, dg = gid >> 6;
      const double dt = exp((double)p.in[10][dg]);
      const double lre = p.in[8][gid], lim = p.in[9][gid];
      const double mag = exp(lre * dt), ang = lim * dt;
      const double are = mag * cos(ang), aim = mag * sin(ang);
      const double den = lre * lre + lim * lim;
      const double zr = are - 1.0, zi = aim;
      const double fr = (zr * lre + zi * lim) / den, fi = (zi * lre - zr * lim) / den;
      double tr = are, ti = aim;
#pragma unroll
      for (int q = 0; q < 5; ++q) { double nr = tr * tr - ti * ti, ni = 2.0 * tr * ti; tr = nr; ti = ni; }
      float* tab = (float*)(ws + OFF_S5AB);
      tab[gid] = (float)are; tab[8192 + gid] = (float)aim; tab[16384 + gid] = (float)tr; tab[24576 + gid] = (float)ti;
      bf16_t* bbf = (bf16_t*)(ws + OFF_BBF);
      bf16_t* cmf = (bf16_t*)(ws + OFF_CMF);
      for (int c = 0; c < 16; ++c) {
        const double bre = p.in[11][(size_t)gid * 16 + c], bim = p.in[12][(size_t)gid * 16 + c];
        const float bbr = (float)(fr * bre - fi * bim), bbi = (float)(fr * bim + fi * bre);
        const int h = c >> 3, jj = c & 7, lane = h * 32 + (pp & 31);
        bbf[((size_t)(dg * 4 + (pp >> 5)) * 64 + lane) * 8 + jj] = f2bf(bbr);
        bbf[((size_t)(dg * 4 + 2 + (pp >> 5)) * 64 + lane) * 8 + jj] = f2bf(bbi);
        const float cre = p.in[13][((size_t)dg * 16 + c) * 64 + pp], cim = p.in[14][((size_t)dg * 16 + c) * 64 + pp];
        const int ks = pp >> 5, q = (pp & 31) >> 3, j2 = pp & 7, lane2 = q * 16 + c;
        cmf[((size_t)(dg * 4 + ks) * 64 + lane2) * 8 + j2] = f2bf(cre);
        cmf[((size_t)(dg * 4 + 2 + ks) * 64 + lane2) * 8 + j2] = f2bf(-cim);
      }
    } else if (idx == T_ADA + T_TR + T_S5) {
      float* rt = (float*)(ws + OFF_ROPE);
      for (int e = tid; e < 2048; e += 256) {
        int pos = e >> 4, i = e & 15;
        float inv = (float)pow(10000.0, -(double)i / 16.0);
        float ang = (float)pos * inv;
        rt[e * 2] = (float)cos((double)ang); rt[e * 2 + 1] = (float)sin((double)ang);
      }
    } else {
      u32x4 z = {0, 0, 0, 0};
      u32x4* d = (u32x4*)((bf16_t*)(ws + OFF_WD) + (size_t)1088 * LDP);
      for (int e = tid; e < 64 * LDP / 8; e += 256) d[e] = z;
    }
  }
}

DEVI void phase_norm(const Params& p, const float* src_lat, const float* src_ctx, const float* gn, int layer, int sh_idx, int sc_idx, int nrows) {
  const int lane = tid_() & 63, wid = tid_() >> 6;
  const float* mod = (const float*)(p.ws + OFF_MOD);
  bf16_t* dst = (bf16_t*)(p.ws + OFF_ACTA);
  for (int row = blockIdx.x * 4 + wid; row < nrows; row += gridDim.x * 4) {
    const float* s; int mr;
    if (row < NLAT) { s = src_lat + (size_t)row * DM; mr = row >> 13; } else { s = src_ctx + (size_t)(row - NLAT) * DM; mr = 4; }
    f32x4 v[4]; float ss = 0;
#pragma unroll
    for (int i = 0; i < 4; ++i) { v[i] = *(const f32x4*)(s + i * 256 + lane * 4); ss += v[i][0] * v[i][0] + v[i][1] * v[i][1] + v[i][2] * v[i][2] + v[i][3] * v[i][3]; }
    ss = wave_sum(ss);
    const float rs = rsqrtf(ss * (1.f / DM) + EPSN);
    const float* shp = mod + (layer * 5 + mr) * 6144 + sh_idx * 1024;
    const float* scp = mod + (layer * 5 + mr) * 6144 + sc_idx * 1024;
    f32x4 gg[4], shh[4], scc[4];
#pragma unroll
    for (int i = 0; i < 4; ++i) { const int c = i * 256 + lane * 4; gg[i] = *(const f32x4*)(gn + c); shh[i] = *(const f32x4*)(shp + c); scc[i] = *(const f32x4*)(scp + c); }
#pragma unroll
    for (int i = 0; i < 4; ++i) {
      const int c = i * 256 + lane * 4;
      float o0 = (v[i][0] * rs * gg[i][0]) * (1.f + scc[i][0]) + shh[i][0];
      float o1 = (v[i][1] * rs * gg[i][1]) * (1.f + scc[i][1]) + shh[i][1];
      float o2 = (v[i][2] * rs * gg[i][2]) * (1.f + scc[i][2]) + shh[i][2];
      float o3 = (v[i][3] * rs * gg[i][3]) * (1.f + scc[i][3]) + shh[i][3];
      u32x2 w = {cvtpk(o0, o1), cvtpk(o2, o3)};
      *(u32x2*)(dst + (size_t)row * LDP + c) = w;
    }
  }
}

template <bool PHASE_C>
DEVI void phase_s5(const Params& p, char* lds) {
  const int lane = tid_() & 63, wid = tid_() >> 6, r32 = lane & 31, hi = lane >> 5;
  float* wl = (float*)(lds + wid * 16896);
  const bf16_t* U = (const bf16_t*)(p.ws + OFF_ACTA);
  bf16_t* Z = (bf16_t*)(p.ws + OFF_ACTB);
  const float* tab = (const float*)(p.ws + OFF_S5AB);
  const bf16x8* bbf = (const bf16x8*)(p.ws + OFF_BBF);
  const bf16x8* cmf = (const bf16x8*)(p.ws + OFF_CMF);
  float* S = (float*)(p.ws + OFF_Y);
  for (int pc = blockIdx.x * 4 + wid; pc < NB * 64 * 8; pc += gridDim.x * 4) {
    const int pair = pc >> 3, sub = pc & 7, b = pair >> 6, g = pair & 63;
    bf16x8 bb[2][4], cm[2][4];
    float arr[2], aii[2];
#pragma unroll
    for (int d = 0; d < 2; ++d) {
      const int dg = d * 64 + g;
#pragma unroll
      for (int nt = 0; nt < 4; ++nt) bb[d][nt] = bbf[(size_t)(dg * 4 + nt) * 64 + lane];
      if (PHASE_C) {
#pragma unroll
        for (int ks = 0; ks < 4; ++ks) cm[d][ks] = cmf[(size_t)(dg * 4 + ks) * 64 + lane];
      }
      arr[d] = tab[dg * 64 + lane]; aii[d] = tab[8192 + dg * 64 + lane];
    }
    const float dsk = PHASE_C ? p.in[15][g * 16 + (lane & 15)] : 0.f;
   for (int kc = sub; kc < NCHUNK; kc += 8) {
    const int tok0 = kc < 256 ? b * SEQL + kc * 32 : NLAT + b * CTXL + (kc - 256) * 32;
    const bf16x8 afrag = *(const bf16x8*)(U + (size_t)(tok0 + r32) * LDP + g * 16 + hi * 8);
    f32x4 y0 = {0, 0, 0, 0}, y1 = {0, 0, 0, 0};
#pragma unroll
    for (int d = 0; d < 2; ++d) {
      const int j = kc < 256 ? (d ? 8 + 255 - kc : 8 + kc) : (d ? 7 - (kc - 256) : (kc - 256));
#pragma unroll
      for (int nt = 0; nt < 4; ++nt) {
        f32x16 acc = {};
        acc = __builtin_amdgcn_mfma_f32_32x32x16_bf16(afrag, bb[d][nt], acc, 0, 0, 0);
#pragma unroll
        for (int i = 0; i < 16; ++i) wl[crow(i, hi) * 132 + nt * 32 + r32] = acc[i];
      }
      asm volatile("s_waitcnt lgkmcnt(0)" ::: "memory");
      const float ar = arr[d], ai = aii[d];
      float hr = 0.f, him = 0.f;
      float* sp = S + ((size_t)((b * 2 + d) * 64 + g) * NCHUNK + j) * 128;
      if (PHASE_C) { hr = sp[lane]; him = sp[64 + lane]; }
      float bur[32], bui[32];
#pragma unroll
      for (int s = 0; s < 32; ++s) { bur[s] = wl[s * 132 + lane]; bui[s] = wl[s * 132 + 64 + lane]; }
#pragma unroll
      for (int s = 0; s < 32; ++s) {
        const int t = d ? 31 - s : s;
        const float nr = ar * hr - ai * him + bur[t];
        const float ni = ar * him + ai * hr + bui[t];
        hr = nr; him = ni;
        if (PHASE_C) { bur[t] = hr; bui[t] = him; }
      }
      if (PHASE_C) {
#pragma unroll
        for (int s = 0; s < 32; ++s) { wl[s * 132 + lane] = bur[s]; wl[s * 132 + 64 + lane] = bui[s]; }
      }
      if (!PHASE_C) { sp[lane] = hr; sp[64 + lane] = him; }
      if (PHASE_C) {
        asm volatile("s_waitcnt lgkmcnt(0)" ::: "memory");
#pragma unroll
        for (int ks = 0; ks < 4; ++ks) {
          const bf16x8 cf = cm[d][ks];
          const float* a0p = wl + (lane & 15) * 132 + ks * 32 + (lane >> 4) * 8;
          const f32x4 a00 = *(const f32x4*)a0p, a01 = *(const f32x4*)(a0p + 4);
          const f32x4 a10 = *(const f32x4*)(a0p + 16 * 132), a11 = *(const f32x4*)(a0p + 16 * 132 + 4);
          u32x4 w0 = {cvtpk(a00[0], a00[1]), cvtpk(a00[2], a00[3]), cvtpk(a01[0], a01[1]), cvtpk(a01[2], a01[3])};
          u32x4 w1 = {cvtpk(a10[0], a10[1]), cvtpk(a10[2], a10[3]), cvtpk(a11[0], a11[1]), cvtpk(a11[2], a11[3])};
          y0 = __builtin_amdgcn_mfma_f32_16x16x32_bf16(*(bf16x8*)&w0, cf, y0, 0, 0, 0);
          y1 = __builtin_amdgcn_mfma_f32_16x16x32_bf16(*(bf16x8*)&w1, cf, y1, 0, 0, 0);
        }
        asm volatile("s_waitcnt lgkmcnt(0)" ::: "memory");
      }
    }
    if (PHASE_C) {
      const int c = lane & 15, ch = g * 16 + c;
      float u0[4], u1[4];
#pragma unroll
      for (int r = 0; r < 4; ++r) {
        const int t0 = (lane >> 4) * 4 + r;
        u0[r] = bf2f(U[(size_t)(tok0 + t0) * LDP + ch]); u1[r] = bf2f(U[(size_t)(tok0 + 16 + t0) * LDP + ch]);
      }
#pragma unroll
      for (int r = 0; r < 4; ++r) {
        const int t0 = (lane >> 4) * 4 + r;
        Z[(size_t)(tok0 + t0) * LDP + ch] = f2bf(gelu_tanh(y0[r] + dsk * u0[r]));
        Z[(size_t)(tok0 + 16 + t0) * LDP + ch] = f2bf(gelu_tanh(y1[r] + dsk * u1[r]));
      }
    }
   }
  }
}

DEVI void phase_s5_state(const Params& p) {
  const int lane = tid_() & 63, wid = tid_() >> 6, r32 = lane & 31, hi = lane >> 5;
  const bf16_t* U = (const bf16_t*)(p.ws + OFF_ACTA);
  const float* tab = (const float*)(p.ws + OFF_S5AB);
  const bf16x8* bbf = (const bf16x8*)(p.ws + OFF_BBF);
  float* S = (float*)(p.ws + OFF_Y);
  for (int pc = blockIdx.x * 4 + wid; pc < NB * 64 * 8; pc += gridDim.x * 4) {
    const int pair = pc >> 3, sub = pc & 7, b = pair >> 6, g = pair & 63;
    bf16x8 bb[2][4];
    float lr_[2][2], li_[2][2], pr_[2][2], pi_[2][2], qr_[2][2], qi_[2][2];
#pragma unroll
    for (int d = 0; d < 2; ++d) {
      const int dg = d * 64 + g;
#pragma unroll
      for (int nt = 0; nt < 4; ++nt) bb[d][nt] = bbf[(size_t)(dg * 4 + nt) * 64 + lane];
#pragma unroll
      for (int st = 0; st < 2; ++st) {
        const float ar = tab[dg * 64 + st * 32 + r32], ai = tab[8192 + dg * 64 + st * 32 + r32];
        const float a2r = ar * ar - ai * ai, a2i = 2.f * ar * ai;
        const float a4r = a2r * a2r - a2i * a2i, a4i = 2.f * a2r * a2i;
        lr_[d][st] = ar; li_[d][st] = ai;
        const bool post = (hi == d);
        pr_[d][st] = post ? 1.f : a4r; pi_[d][st] = post ? 0.f : a4i;
        qr_[d][st] = post ? a4r : 1.f; qi_[d][st] = post ? a4i : 0.f;
      }
    }
    for (int kc = sub; kc < NCHUNK; kc += 8) {
      const int tok0 = kc < 256 ? b * SEQL + kc * 32 : NLAT + b * CTXL + (kc - 256) * 32;
      const bf16x8 afrag = *(const bf16x8*)(U + (size_t)(tok0 + r32) * LDP + g * 16 + hi * 8);
#pragma unroll
      for (int d = 0; d < 2; ++d) {
        const int j = kc < 256 ? (d ? 8 + 255 - kc : 8 + kc) : (d ? 7 - (kc - 256) : (kc - 256));
        float* sp = S + ((size_t)((b * 2 + d) * 64 + g) * NCHUNK + j) * 128;
#pragma unroll
        for (int st = 0; st < 2; ++st) {
          f32x16 acr = {}, aci = {};
          acr = __builtin_amdgcn_mfma_f32_32x32x16_bf16(afrag, bb[d][st], acr, 0, 0, 0);
          aci = __builtin_amdgcn_mfma_f32_32x32x16_bf16(afrag, bb[d][st + 2], aci, 0, 0, 0);
          const float ar = lr_[d][st], ai = li_[d][st];
          float hr = 0.f, him = 0.f;
#pragma unroll
          for (int g4 = 0; g4 < 4; ++g4) {
            const int G = d ? 3 - g4 : g4;
            { const float nr = pr_[d][st] * hr - pi_[d][st] * him, ni = pr_[d][st] * him + pi_[d][st] * hr; hr = nr; him = ni; }
#pragma unroll
            for (int jj = 0; jj < 4; ++jj) {
              const int i = G * 4 + (d ? 3 - jj : jj);
              const float nr = ar * hr - ai * him + acr[i];
              const float ni = ar * him + ai * hr + aci[i];
              hr = nr; him = ni;
            }
            { const float nr = qr_[d][st] * hr - qi_[d][st] * him, ni = qr_[d][st] * him + qi_[d][st] * hr; hr = nr; him = ni; }
          }
          { auto rr = __builtin_amdgcn_permlane32_swap(__float_as_uint(hr), __float_as_uint(hr), false, false);
            hr = __uint_as_float(rr[0]) + __uint_as_float(rr[1]); }
          { auto rr = __builtin_amdgcn_permlane32_swap(__float_as_uint(him), __float_as_uint(him), false, false);
            him = __uint_as_float(rr[0]) + __uint_as_float(rr[1]); }
          if (hi == st) { sp[st * 32 + r32] = hr; sp[64 + st * 32 + r32] = him; }
        }
      }
    }
  }
}

DEVI void phase_s5_carry(const Params& p) {
  const int lane = tid_() & 63, wid = tid_() >> 6;
  const float* tab = (const float*)(p.ws + OFF_S5AB);
  float* S = (float*)(p.ws + OFF_Y);
  for (int task = blockIdx.x * 4 + wid; task < NB * 2 * 64; task += gridDim.x * 4) {
    const int g = task & 63, d = (task >> 6) & 1;
    const float lr = tab[16384 + (d * 64 + g) * 64 + lane], li = tab[24576 + (d * 64 + g) * 64 + lane];
    float* sp = S + (size_t)task * NCHUNK * 128;
    float hr = 0.f, him = 0.f;
    float tr[8], ti[8], ur[8], ui[8];
#pragma unroll
    for (int q = 0; q < 8; ++q) { tr[q] = sp[q * 128 + lane]; ti[q] = sp[q * 128 + 64 + lane]; }
    for (int j0 = 0; j0 < NCHUNK; j0 += 8) {
      if (j0 + 8 < NCHUNK) {
#pragma unroll
        for (int q = 0; q < 8; ++q) { ur[q] = sp[(j0 + 8 + q) * 128 + lane]; ui[q] = sp[(j0 + 8 + q) * 128 + 64 + lane]; }
      }
#pragma unroll
      for (int q = 0; q < 8; ++q) {
        sp[(j0 + q) * 128 + lane] = hr; sp[(j0 + q) * 128 + 64 + lane] = him;
        const float nr = lr * hr - li * him + tr[q];
        const float ni = lr * him + li * hr + ti[q];
        hr = nr; him = ni;
      }
#pragma unroll
      for (int q = 0; q < 8; ++q) { tr[q] = ur[q]; ti[q] = ui[q]; }
    }
  }
}

constexpr float QSCALE = 0.07216878364870322f * 1.4426950408889634f;
enum { EPI_GLU = 0, EPI_RES = 1, EPI_FFNIN = 2, EPI_G1 = 3, EPI_Q = 4, EPI_KV = 5 };

DEVI void rope64(float* v, const float* rt, int t) {
  const float* rr = rt + (t >> 6) * 32;
  const float* rc = rt + (t & 63) * 32;
#pragma unroll
  for (int i = 0; i < 16; ++i) {
    float c = rr[i * 2], s = rr[i * 2 + 1], x1 = v[i], x2 = v[16 + i];
    v[i] = x1 * c - x2 * s; v[16 + i] = x1 * s + x2 * c;
    c = rc[i * 2]; s = rc[i * 2 + 1]; x1 = v[32 + i]; x2 = v[48 + i];
    v[32 + i] = x1 * c - x2 * s; v[48 + i] = x1 * s + x2 * c;
  }
}
DEVI void store64bf(bf16_t* dst, const float* v) {
#pragma unroll
  for (int c = 0; c < 64; c += 8) {
    u32x4 w = {cvtpk(v[c], v[c + 1]), cvtpk(v[c + 2], v[c + 3]), cvtpk(v[c + 4], v[c + 5]), cvtpk(v[c + 6], v[c + 7])};
    *(u32x4*)(dst + c) = w;
  }
}

template <int EPI, bool GUARD>
DEVI void gemm_tile(const Params& p, const bf16_t* __restrict__ A, int lda, const bf16_t* __restrict__ Bt, int ldb, int K,
                          int row_base, int row_lo, int row_hi, int tile_n, int layer, int which, char* lds) {
  const int tid = tid_(), lane = tid & 63, wid = tid >> 6, wr = wid >> 1, wc = wid & 1, c16 = lane & 15, q4 = lane >> 4;
  f32x4 acc[4][4] = {};
  const int wq = __builtin_amdgcn_readfirstlane(wid) * 4;
  const int lrow = lane >> 3, lcp = lane & 7;
  const char* Abase = (const char*)(A + (long)row_base * lda);
  const char* Bbase = (const char*)(Bt + (long)(tile_n * 128) * ldb);
  unsigned aoff[4], boff[4];
#pragma unroll
  for (int e = 0; e < 4; ++e) {
    const int r = (wq + e) * 8 + lrow;
    const int kc = lcp ^ ((r >> 1) & 7);
    int gr = row_base + r;
    if (GUARD) gr = gr < row_lo ? row_lo : (gr >= row_hi ? row_hi - 1 : gr);
    aoff[e] = (unsigned)(((gr - row_base) * lda + kc * 8) * 2);
    boff[e] = (unsigned)((r * ldb + kc * 8) * 2);
  }
#define GISSUE(k0, buf) do { const char* ak_ = Abase + (size_t)(k0) * 2; const char* bk_ = Bbase + (size_t)(k0) * 2; _Pragma("unroll") for (int e = 0; e < 4; ++e) { \
      __builtin_amdgcn_global_load_lds((const unsigned*)(ak_ + aoff[e]), (unsigned*)(lds + (buf) * 32768 + (wq + e) * 1024), 16, 0, 0); \
      __builtin_amdgcn_global_load_lds((const unsigned*)(bk_ + boff[e]), (unsigned*)(lds + (buf) * 32768 + 16384 + (wq + e) * 1024), 16, 0, 0); } } while (0)
  const int swz = c16 >> 1;
  int koff[2];
#pragma unroll
  for (int ks = 0; ks < 2; ++ks) koff[ks] = ((ks * 4 + q4) ^ swz) << 4;
  const int arow = (wr * 64 + c16) * 128, brow = 16384 + (wc * 64 + c16) * 128;
#define KSTEPS(buf) do { const char* Lb = lds + (buf) * 32768; _Pragma("unroll") for (int ks = 0; ks < 2; ++ks) { \
      bf16x8 af[4], bfr[4]; \
      _Pragma("unroll") for (int t = 0; t < 4; ++t) { af[t] = *(const bf16x8*)(Lb + arow + t * 2048 + koff[ks]); bfr[t] = *(const bf16x8*)(Lb + brow + t * 2048 + koff[ks]); } \
      _Pragma("unroll") for (int mt = 0; mt < 4; ++mt) _Pragma("unroll") for (int nt = 0; nt < 4; ++nt) \
        acc[mt][nt] = __builtin_amdgcn_mfma_f32_16x16x32_bf16(af[mt], bfr[nt], acc[mt][nt], 0, 0, 0); } } while (0)
#define GBAR() do { asm volatile("s_waitcnt vmcnt(0) lgkmcnt(0)" ::: "memory"); __builtin_amdgcn_s_barrier(); } while (0)
  GISSUE(0, 0); GBAR();
  for (int k0 = 0; k0 < K; k0 += 128) {
    GISSUE(k0 + 64, 1);
    KSTEPS(0);
    GBAR();
    if (k0 + 128 < K) GISSUE(k0 + 128, 0);
    KSTEPS(1);
    GBAR();
  }
#undef GISSUE
#undef KSTEPS
#undef GBAR
  const float* mod = (const float*)(p.ws + OFF_MOD);
  float* ctxr = (float*)(p.ws + OFF_CTXR);
  if (EPI == EPI_GLU) {
    const float* gb = p.in[17];
    const int j0 = tile_n * 64 + wc * 32 + c16;
    const bool lat = row_base < NLAT;
    const float* mg = mod + (lat ? (row_base >> 13) : 4) * 6144 + 2048;
    const float ba0 = gb[j0], ba1 = gb[j0 + 16], bg0 = gb[1024 + j0], bg1 = gb[1024 + j0 + 16], gt0 = mg[j0], gt1 = mg[j0 + 16];
    const float* xin = (lat ? p.in[0] + (size_t)row_base * DM : p.in[2] + (size_t)(row_base - NLAT) * DM) + j0;
    float* xo = (lat ? p.out + (size_t)row_base * DM : ctxr + (size_t)(row_base - NLAT) * DM) + j0;
#pragma unroll
    for (int mh = 0; mh < 2; ++mh) {
      float xv[2][2][4];
#pragma unroll
      for (int m2 = 0; m2 < 2; ++m2)
#pragma unroll
        for (int jj = 0; jj < 4; ++jj) { const size_t ro = (size_t)(wr * 64 + (mh * 2 + m2) * 16 + q4 * 4 + jj) * DM; xv[m2][0][jj] = xin[ro]; xv[m2][1][jj] = xin[ro + 16]; }
#pragma unroll
      for (int m2 = 0; m2 < 2; ++m2)
#pragma unroll
        for (int jj = 0; jj < 4; ++jj) {
          const int mt = mh * 2 + m2; const size_t ro = (size_t)(wr * 64 + mt * 16 + q4 * 4 + jj) * DM;
          xo[ro] = xv[m2][0][jj] + gt0 * ((acc[mt][0][jj] + ba0) * sigmoidf_(acc[mt][2][jj] + bg0));
          xo[ro + 16] = xv[m2][1][jj] + gt1 * ((acc[mt][1][jj] + ba1) * sigmoidf_(acc[mt][3][jj] + bg1));
        }
    }
    return;
  }
  if (EPI == EPI_RES) {
    const bool lat = row_base < NLAT;
    const float* gp = mod + (layer * 5 + (lat ? (row_base >> 13) : 4)) * 6144 + which * 1024 + tile_n * 128 + wc * 64 + c16;
    const float g0 = gp[0], g1 = gp[16], g2 = gp[32], g3 = gp[48];
    float* xo = (lat ? p.out + (size_t)row_base * DM : ctxr + (size_t)(row_base - NLAT) * DM) + tile_n * 128 + wc * 64 + c16;
#pragma unroll
    for (int mh = 0; mh < 2; ++mh) {
      float xv[2][4][4];
#pragma unroll
      for (int m2 = 0; m2 < 2; ++m2)
#pragma unroll
        for (int jj = 0; jj < 4; ++jj) { const size_t ro = (size_t)(wr * 64 + (mh * 2 + m2) * 16 + q4 * 4 + jj) * DM;
          xv[m2][0][jj] = xo[ro]; xv[m2][1][jj] = xo[ro + 16]; xv[m2][2][jj] = xo[ro + 32]; xv[m2][3][jj] = xo[ro + 48]; }
#pragma unroll
      for (int m2 = 0; m2 < 2; ++m2)
#pragma unroll
        for (int jj = 0; jj < 4; ++jj) { const int mt = mh * 2 + m2; const size_t ro = (size_t)(wr * 64 + mt * 16 + q4 * 4 + jj) * DM;
          xo[ro] = xv[m2][0][jj] + g0 * acc[mt][0][jj]; xo[ro + 16] = xv[m2][1][jj] + g1 * acc[mt][1][jj];
          xo[ro + 32] = xv[m2][2][jj] + g2 * acc[mt][2][jj]; xo[ro + 48] = xv[m2][3][jj] + g3 * acc[mt][3][jj]; }
    }
    return;
  }
  float* ldsC = (float*)lds;
#pragma unroll
  for (int mt = 0; mt < 4; ++mt)
#pragma unroll
    for (int nt = 0; nt < 4; ++nt)
#pragma unroll
      for (int jj = 0; jj < 4; ++jj)
        ldsC[(wr * 64 + mt * 16 + q4 * 4 + jj) * 132 + wc * 64 + nt * 16 + c16] = acc[mt][nt][jj];
  __syncthreads();
  const int lr = tid >> 1, half = tid & 1;
  const int tok = row_base + lr;
  const float* cr = ldsC + lr * 132 + half * 64;
  if (EPI == EPI_FFNIN) {
    const int jc = tid & 7, rg = tid >> 3;
    const int ca = (jc >> 2) * 64 + (jc & 3) * 8;
    const int f0 = tile_n * 64 + jc * 8;
    const float* cw = p.in[30] + layer * 3 * FF + f0; const float* cbp = p.in[31] + layer * FF + f0;
    float w0[8], w1[8], w2[8], cb[8];
#pragma unroll
    for (int u = 0; u < 8; ++u) { w0[u] = cw[u]; w1[u] = cw[FF + u]; w2[u] = cw[2 * FF + u]; cb[u] = cbp[u]; }
    const int lr0 = rg * 4;
    float ap[8], ac[8], an[8];
    {
      const float* c0 = ldsC + (lr0 > 0 ? lr0 - 1 : 0) * 132 + ca;
      const float* c1 = ldsC + lr0 * 132 + ca;
#pragma unroll
      for (int u = 0; u < 8; ++u) { ap[u] = c0[u]; ac[u] = c1[u]; }
    }
    u32x4 outw[4];
    bool outv[4];
#pragma unroll
    for (int q = 0; q < 4; ++q) {
      const int lrq = lr0 + q, tk = row_base + lrq;
      const float* cn = ldsC + (lrq < 127 ? lrq + 1 : 127) * 132 + ca;
      const float* cbv = ldsC + lrq * 132 + ca + 32;
#pragma unroll
      for (int u = 0; u < 8; ++u) an[u] = cn[u];
      const int seqlen = tk < NLAT ? SEQL : CTXL;
      const int pos = tk < NLAT ? (tk & (SEQL - 1)) : ((tk - NLAT) & (CTXL - 1));
      const bool hp = pos > 0, hn = pos < seqlen - 1;
      float m[8];
#pragma unroll
      for (int u = 0; u < 8; ++u) {
        const float conv = cb[u] + (hp ? ap[u] * w0[u] : 0.f) + ac[u] * w1[u] + (hn ? an[u] * w2[u] : 0.f);
        m[u] = conv * sigmoidf_(conv) * cbv[u];
      }
      outw[q] = (u32x4){cvtpk(m[0], m[1]), cvtpk(m[2], m[3]), cvtpk(m[4], m[5]), cvtpk(m[6], m[7])};
      outv[q] = lrq >= 1 && lrq <= 126 && tk >= row_lo && tk < row_hi;
#pragma unroll
      for (int u = 0; u < 8; ++u) { ap[u] = ac[u]; ac[u] = an[u]; }
    }
    bf16_t* dst = (bf16_t*)(p.ws + OFF_X) + f0;
#pragma unroll
    for (int q = 0; q < 4; ++q) if (outv[q]) *(u32x4*)(dst + (size_t)(row_base + lr0 + q) * FF) = outw[q];
  }
  if (EPI == EPI_G1) {
    if (tile_n < 8) {
      float v[64]; float ss = 0;
#pragma unroll
      for (int c = 0; c < 64; ++c) { v[c] = cr[c]; ss += v[c] * v[c]; }
      ss += __shfl_xor(ss, 1);
      store64bf((bf16_t*)(p.ws + OFF_Y) + (size_t)tok * 1152 + tile_n * 128 + half * 64, v);
      if (half == 0) ((float*)(p.ws + OFF_SSQ))[(size_t)tok * 8 + tile_n] = ss;
    } else if (half == 0) {
      float v[64]; float ss = 0;
#pragma unroll
      for (int c = 0; c < 64; ++c) { v[c] = cr[c]; ss += v[c] * v[c]; }
      const float rs = rsqrtf(ss * (1.f / 64.f) + EPSN);
      const float* gk = p.in[27];
#pragma unroll
      for (int c = 0; c < 64; ++c) v[c] = v[c] * rs * gk[c];
      int b, pos;
      if (tok < NLAT) { b = tok >> 13; const int t = tok & (SEQL - 1); pos = CTXL + t; rope64(v, (const float*)(p.ws + OFF_ROPE), t); }
      else { b = (tok - NLAT) >> 8; pos = (tok - NLAT) & (CTXL - 1); }
      bf16_t* kb = (bf16_t*)(p.ws + OFF_K) + ((size_t)(b * 8) * KVL + pos) * 192 + 128;
#pragma unroll
      for (int c = 0; c < 64; c += 8) {
        u32x4 w = {cvtpk(v[c], v[c + 1]), cvtpk(v[c + 2], v[c + 3]), cvtpk(v[c + 4], v[c + 5]), cvtpk(v[c + 6], v[c + 7])};
#pragma unroll
        for (int h = 0; h < 8; ++h) *(u32x4*)(kb + (size_t)h * KVL * 192 + c) = w;
      }
    }
  }
  if (EPI == EPI_Q) {
    const float* sq = (const float*)(p.ws + OFF_SSQ) + (size_t)tok * 8;
    const float rq = rsqrtf((sq[0] + sq[1] + sq[2] + sq[3] + sq[4] + sq[5]) * (1.f / 768.f) + EPSN);
    const int b = tok >> 13, t = tok & (SEQL - 1);
    float v[64]; float ss = 0;
#pragma unroll
    for (int c = 0; c < 64; ++c) { v[c] = cr[c] * rq; ss += v[c] * v[c]; }
    bf16_t* qb = (bf16_t*)(p.ws + OFF_X);
    if (tile_n < 8) {
      ss += __shfl_xor(ss, 1);
      const float rs = rsqrtf(ss * (1.f / 128.f) + EPSN) * QSCALE;
      const float* gq = p.in[24] + half * 64;
#pragma unroll
      for (int c = 0; c < 64; ++c) v[c] = v[c] * rs * gq[c];
      store64bf(qb + ((size_t)(b * 8 + tile_n) * SEQL + t) * 192 + half * 64, v);
    } else {
      const int head = (tile_n - 8) * 2 + half;
      const float rs = rsqrtf(ss * (1.f / 64.f) + EPSN) * QSCALE;
      const float* gq = p.in[25];
#pragma unroll
      for (int c = 0; c < 64; ++c) v[c] = v[c] * rs * gq[c];
      rope64(v, (const float*)(p.ws + OFF_ROPE), t);
      store64bf(qb + ((size_t)(b * 8 + head) * SEQL + t) * 192 + 128, v);
    }
  }
  if (EPI == EPI_KV) {
    const float* sq = (const float*)(p.ws + OFF_SSQ) + (size_t)tok * 8;
    const float rkv = rsqrtf((sq[6] + sq[7]) * (1.f / 256.f) + EPSN);
    int b, pos;
    if (tok < NLAT) { b = tok >> 13; pos = CTXL + (tok & (SEQL - 1)); } else { b = (tok - NLAT) >> 8; pos = (tok - NLAT) & (CTXL - 1); }
    const int head = tile_n >> 1;
    float v[64]; float ss = 0;
#pragma unroll
    for (int c = 0; c < 64; ++c) { v[c] = cr[c] * rkv; ss += v[c] * v[c]; }
    if ((tile_n & 1) == 0) {
      ss += __shfl_xor(ss, 1);
      const float rs = rsqrtf(ss * (1.f / 128.f) + EPSN);
      const float* gk = p.in[26] + half * 64;
#pragma unroll
      for (int c = 0; c < 64; ++c) v[c] = v[c] * rs * gk[c];
      store64bf((bf16_t*)(p.ws + OFF_K) + ((size_t)(b * 8 + head) * KVL + pos) * 192 + half * 64, v);
    } else {
      store64bf((bf16_t*)(p.ws + OFF_ACTA) + ((size_t)(b * 8 + head) * KVL + pos) * 128 + half * 64, v);
    }
  }
  __syncthreads();
}

constexpr float ASCALE = 0.07216878364870322f;
constexpr float ATHR = 8.f;
constexpr int KROW = 400;
constexpr int K_LDS_BYTES = 64 * KROW;
constexpr int V_LDS_BYTES = 64 * 128 * 2;

DEVI void partialSM(f32x16& p0, f32x16& p1, float& m_reg, float& mn, float& alpha) {
  constexpr float L2E = 1.4426950408889634f;
  float pmax = p0[0];
#pragma unroll
  for (int r = 1; r < 16; ++r) pmax = fmaxf(pmax, p0[r]);
#pragma unroll
  for (int r = 0; r < 16; ++r) pmax = fmaxf(pmax, p1[r]);
  { auto rr = __builtin_amdgcn_permlane32_swap(__float_as_uint(pmax), __float_as_uint(pmax), false, false);
    pmax = fmaxf(__uint_as_float(rr[0]), __uint_as_float(rr[1])); }
  if (__builtin_expect(__all(pmax - m_reg <= ATHR * L2E), 1)) { mn = m_reg; alpha = 1.f; }
  else { mn = fmaxf(m_reg, pmax); alpha = __builtin_amdgcn_exp2f(m_reg - mn); m_reg = mn; }
#pragma unroll
  for (int r = 0; r < 16; ++r) p0[r] = __builtin_amdgcn_exp2f(p0[r] - mn);
#pragma unroll
  for (int r = 0; r < 16; ++r) p1[r] = __builtin_amdgcn_exp2f(p1[r] - mn);
}
DEVI void finishSM(f32x16& p0, f32x16& p1, float alpha, float& l_reg, bf16x8& pa0, bf16x8& pa1, bf16x8& pa2, bf16x8& pa3) {
  float ps = 0;
#pragma unroll
  for (int r = 0; r < 16; ++r) ps += p0[r];
#pragma unroll
  for (int r = 0; r < 16; ++r) ps += p1[r];
  { auto rr = __builtin_amdgcn_permlane32_swap(__float_as_uint(ps), __float_as_uint(ps), false, false);
    ps = __uint_as_float(rr[0]) + __uint_as_float(rr[1]); }
  l_reg = l_reg * alpha + ps;
#define PK4(P, BASE, OUT) do { unsigned a0 = cvtpk(P[BASE + 0], P[BASE + 1]), a1 = cvtpk(P[BASE + 2], P[BASE + 3]);   \
    unsigned b0 = cvtpk(P[BASE + 4], P[BASE + 5]), b1 = cvtpk(P[BASE + 6], P[BASE + 7]);                              \
    auto r0 = __builtin_amdgcn_permlane32_swap(a0, b0, false, false); auto r1 = __builtin_amdgcn_permlane32_swap(a1, b1, false, false); \
    u32x4 w = {r0[0], r1[0], r0[1], r1[1]}; OUT = *reinterpret_cast<bf16x8*>(&w); } while (0)
  PK4(p0, 0, pa0); PK4(p0, 8, pa1); PK4(p1, 0, pa2); PK4(p1, 8, pa3);
#undef PK4
}
DEVI int v_st(int k) { const int kk = (k & ~0xC) | ((k & 4) << 1) | ((k & 8) >> 1); return ((kk >> 3) * 4) * 512 + ((kk & 7) * 32) * 2; }
DEVI int v_rd_base(int lane) { return ((lane & 3) << 3) | (((lane >> 2) & 3) << 6) | (((lane >> 4) & 1) << 5) | (((lane >> 5) & 1) << 8); }
constexpr int v_rd_off(int d0, int ks, int half) { return d0 * 512 + ks * 4096 + half * 2048; }
template <int OFF> DEVI s16x4 tr_read(int vb) {
  s16x4 r; asm volatile("ds_read_b64_tr_b16 %0, %1 offset:%2" : "=&v"(r) : "v"(vb), "i"(OFF) : "memory"); return r;
}
template <int D0> DEVI void pv_one(f32x16& od, int vb, bf16x8 pa0, bf16x8 pa1, bf16x8 pa2, bf16x8 pa3) {
  const s16x4 l0 = tr_read<v_rd_off(D0, 0, 0)>(vb), h0 = tr_read<v_rd_off(D0, 0, 1)>(vb), l1 = tr_read<v_rd_off(D0, 1, 0)>(vb), h1 = tr_read<v_rd_off(D0, 1, 1)>(vb);
  const s16x4 l2 = tr_read<v_rd_off(D0, 2, 0)>(vb), h2 = tr_read<v_rd_off(D0, 2, 1)>(vb), l3 = tr_read<v_rd_off(D0, 3, 0)>(vb), h3 = tr_read<v_rd_off(D0, 3, 1)>(vb);
  asm volatile("s_waitcnt lgkmcnt(0)" ::: "memory"); SBAR();
#define PK(L, H) (bf16x8){L[0], L[1], L[2], L[3], H[0], H[1], H[2], H[3]}
  od = __builtin_amdgcn_mfma_f32_32x32x16_bf16(pa0, PK(l0, h0), od, 0, 0, 0);
  od = __builtin_amdgcn_mfma_f32_32x32x16_bf16(pa1, PK(l1, h1), od, 0, 0, 0);
  od = __builtin_amdgcn_mfma_f32_32x32x16_bf16(pa2, PK(l2, h2), od, 0, 0, 0);
  od = __builtin_amdgcn_mfma_f32_32x32x16_bf16(pa3, PK(l3, h3), od, 0, 0, 0);
#undef PK
}

template <bool FIXED>
DEVI void attn_task(const bf16_t* __restrict__ Qb, const bf16_t* __restrict__ Kh, const bf16_t* __restrict__ Vh, bf16_t* __restrict__ Ob, char* lds, float shiftC) {
  const int tid = tid_(), wid = tid >> 6, lane = tid & 63, r32 = lane & 31, hi = lane >> 5;
  const int wu = __builtin_amdgcn_readfirstlane(wid);
  char* K_lds = lds; char* V_lds = lds + 24576;
  float* wsf = (float*)(lds + 24576 + 16384) + wid * 64; float* li_l = wsf; float* al_l = wsf + 32;
  float m_reg = -1e30f, l_reg = 0.f;
  f32x16 o[4] = {};
  bf16x8 qr[12];
  {
    const char* Qc = (const char*)Qb;
    const unsigned qoff = (unsigned)((wid * 32 + r32) * 192 + hi * 8) * 2u;
#pragma unroll
    for (int d0 = 0; d0 < 12; ++d0) qr[d0] = *(const bf16x8*)(Qc + (qoff + d0 * 32));
  }
  const char* Kc = (const char*)Kh; const char* Vc = (const char*)Vh;
  unsigned ksrc[6], vsrc[4];
#pragma unroll
  for (int e = 0; e < 6; ++e) {
    const unsigned byte = (unsigned)((wu * 6 + e) * 1024 + lane * 16);
    const unsigned r = byte / 384u, cpos = (byte - r * 384u) >> 4;
    ksrc[e] = r * 384u + (((cpos & ~7u) | ((cpos & 7u) ^ ((r >> 1) & 7u))) << 4);
  }
#pragma unroll
  for (int e = 0; e < 4; ++e) {
    const int st = 2 * (wu * 4 + e) + (lane >> 5);
    const int kk = (st >> 2) * 8 + ((lane & 31) >> 2), c = (st & 3) * 32 + (lane & 3) * 8;
    const int k = (kk & ~0xC) | ((kk & 4) << 1) | ((kk & 8) >> 1);
    vsrc[e] = (unsigned)(k * 256 + c * 2);
  }
#define KISSUE(k0) do { const char* kp_ = Kc + (size_t)(k0) * 384; _Pragma("unroll") for (int e = 0; e < 6; ++e) \
      __builtin_amdgcn_global_load_lds((const unsigned*)(kp_ + ksrc[e]), (unsigned*)(K_lds + (wu * 6 + e) * 1024), 16, 0, 0); } while (0)
#define VISSUE(k0) do { const char* vp_ = Vc + (size_t)(k0) * 256; _Pragma("unroll") for (int e = 0; e < 4; ++e) \
      __builtin_amdgcn_global_load_lds((const unsigned*)(vp_ + vsrc[e]), (unsigned*)(V_lds + (wu * 4 + e) * 1024), 16, 0, 0); } while (0)
#define ABAR() do { asm volatile("s_waitcnt vmcnt(0) lgkmcnt(0)" ::: "memory"); __builtin_amdgcn_s_barrier(); } while (0)
  const int vb0 = (int)(uintptr_t)V_lds + v_rd_base(lane);
  const int swz = (r32 >> 1) & 7;
  int kx[4];
#pragma unroll
  for (int i = 0; i < 4; ++i) kx[i] = ((2 * i + hi) ^ swz) << 4;
  const char* Kr0 = K_lds + r32 * 384;
  KISSUE(0); VISSUE(0); ABAR();
  constexpr int NT = KVL / 64;
  for (int j = 0; j < NT; ++j) {
    f32x16 p0 = {}, p1 = {};
#pragma unroll
    for (int d0 = 0; d0 < 12; ++d0) {
      const bf16x8 b0 = *(const bf16x8*)(Kr0 + (d0 >> 2) * 128 + kx[d0 & 3]);
      const bf16x8 b1 = *(const bf16x8*)(Kr0 + 32 * 384 + (d0 >> 2) * 128 + kx[d0 & 3]);
      p0 = __builtin_amdgcn_mfma_f32_32x32x16_bf16(b0, qr[d0], p0, 0, 0, 0);
      p1 = __builtin_amdgcn_mfma_f32_32x32x16_bf16(b1, qr[d0], p1, 0, 0, 0);
    }
    ABAR();
    if (j + 1 < NT) KISSUE((j + 1) * 64);
    float mn, alpha = 1.f;
    if constexpr (FIXED) {
#pragma unroll
      for (int r = 0; r < 16; ++r) p0[r] = __builtin_amdgcn_exp2f(p0[r]);
#pragma unroll
      for (int r = 0; r < 16; ++r) p1[r] = __builtin_amdgcn_exp2f(p1[r]);
    } else partialSM(p0, p1, m_reg, mn, alpha);
    if (!FIXED && __any(alpha < 1.f)) {
      if (hi == 0) al_l[r32] = alpha;
      asm volatile("s_waitcnt lgkmcnt(0)" ::: "memory");
#pragma unroll
      for (int r = 0; r < 16; ++r) { const float a = al_l[crow(r, hi)];
#pragma unroll
        for (int d = 0; d < 4; ++d) o[d][r] *= a; }
    }
    bf16x8 pa0, pa1, pa2, pa3;
    finishSM(p0, p1, alpha, l_reg, pa0, pa1, pa2, pa3);
    pv_one<0>(o[0], vb0, pa0, pa1, pa2, pa3); pv_one<1>(o[1], vb0, pa0, pa1, pa2, pa3);
    pv_one<2>(o[2], vb0, pa0, pa1, pa2, pa3); pv_one<3>(o[3], vb0, pa0, pa1, pa2, pa3);
    ABAR();
    if (j + 1 < NT) VISSUE((j + 1) * 64);
  }
#undef KISSUE
#undef VISSUE
#undef ABAR
  if (hi == 0) li_l[r32] = l_reg;
  asm volatile("s_waitcnt lgkmcnt(0)" ::: "memory");
  char* Oc = (char*)Ob;
#pragma unroll
  for (int r = 0; r < 16; ++r) {
    const int orow = crow(r, hi);
    const float rl = 1.f / li_l[orow];
    const unsigned ooff = (unsigned)((wid * 32 + orow) * LDP + r32) * 2u;
#pragma unroll
    for (int d0 = 0; d0 < 4; ++d0) *(bf16_t*)(Oc + (ooff + d0 * 64)) = f2bf(o[d0][r] * rl);
  }
  __syncthreads();
}

#define XB_TMO      128
#define XB_XCNT(j)  (256  + 64 * (j))
#define XB_XSUB(j)  (1280 + 64 * (j))
#define XB_XGEN(j)  (2304 + 64 * (j))
#define XB_TOP      3328
#define XB_TOPGEN   3392
#define XCD_BAR_WORDS 3456
#define XB_SPIN_CAP (1u << 24)
#define LAS __attribute__((address_space(3)))
DEVI unsigned xb_ld(unsigned* p)              { return __hip_atomic_load(p, __ATOMIC_RELAXED, __HIP_MEMORY_SCOPE_AGENT); }
DEVI unsigned xb_add(unsigned* p, unsigned v) { return __hip_atomic_fetch_add(p, v, __ATOMIC_RELAXED, __HIP_MEMORY_SCOPE_AGENT); }
DEVI unsigned xb_xcc_id() { return (unsigned)__builtin_amdgcn_s_getreg((3 << 11) | 20) & 0xFu; }
#define XB_SPIN(cond, bar) do { unsigned _sp = 0; while (cond) { __builtin_amdgcn_s_sleep(1); \
    if ((++_sp & 255u) == 0u) { if (xb_ld(&(bar)[XB_TMO])) break; if (_sp > XB_SPIN_CAP) { atomicAdd(&(bar)[XB_TMO], 1u); break; } } } } while (0)
struct XcdBarrier { unsigned* bar; unsigned x; volatile LAS unsigned* st; };
DEVI XcdBarrier xcd_barrier_post(unsigned* bar, volatile LAS unsigned* st) {
  XcdBarrier b; b.bar = bar; b.x = xb_xcc_id(); b.st = st;
  if (threadIdx.x == 0) (void)xb_add(&bar[XB_XCNT(b.x)], 1u);
  return b;
}
DEVI void xcd_barrier_complete(unsigned* bar, unsigned x, unsigned& nloc, unsigned& nx) {
  const unsigned G = gridDim.x * gridDim.y * gridDim.z;
  unsigned sum, cnt, mine, sp = 0u;
  for (;;) {
    sum = 0u; cnt = 0u; mine = 0u;
#pragma unroll
    for (unsigned j = 0; j < 16; ++j) { const unsigned c = xb_ld(&bar[XB_XCNT(j)]); sum += c; cnt += (c > 0u) ? 1u : 0u; mine = (j == x) ? c : mine; }
    if (sum == G) break;
    __builtin_amdgcn_s_sleep(1);
    if ((++sp & 255u) == 0u) { if (xb_ld(&bar[XB_TMO])) break; if (sp > XB_SPIN_CAP) { atomicAdd(&bar[XB_TMO], 1u); break; } }
  }
  nloc = mine > 0u ? mine : 1u; nx = cnt > 0u ? cnt : 1u;
}
DEVI void xcd_barrier(const XcdBarrier& b) {
  asm volatile("s_waitcnt vmcnt(0)" ::: "memory");
  __syncthreads();
  if (threadIdx.x == 0) {
    unsigned* bar = b.bar;
    __builtin_amdgcn_s_waitcnt(0);
    unsigned nloc = b.st[0], nx = b.st[1];
    if (nloc == 0u) { xcd_barrier_complete(bar, b.x, nloc, nx); b.st[0] = nloc; b.st[1] = nx; }
    const unsigned old = xb_add(&bar[XB_XSUB(b.x)], 1u);
    const unsigned gen = old / nloc;
    if (old + 1u == (gen + 1u) * nloc) {
      __builtin_amdgcn_fence(__ATOMIC_RELEASE, "agent");
      asm volatile("s_waitcnt vmcnt(0)" ::: "memory");
      const unsigned og = xb_add(&bar[XB_TOP], 1u);
      const unsigned tg = og / nx;
      if (og + 1u == (tg + 1u) * nx) xb_add(&bar[XB_TOPGEN], 1u);
      else XB_SPIN(xb_ld(&bar[XB_TOPGEN]) == tg, bar);
      __builtin_amdgcn_fence(__ATOMIC_ACQUIRE, "agent");
      xb_add(&bar[XB_XGEN(b.x)], 1u);
      asm volatile("s_waitcnt vmcnt(0)" ::: "memory");
    } else {
      XB_SPIN(xb_ld(&bar[XB_XGEN(b.x)]) == gen, bar);
      __builtin_amdgcn_fence(__ATOMIC_ACQUIRE, "agent");
      asm volatile("s_waitcnt vmcnt(0)" ::: "memory");
    }
  }
  __syncthreads();
}

#define GEMM_LOOP(MT, NT, SM, SN, ...) \
  { const int xcd_ = blockIdx.x & 7; constexpr int SNT_ = ((NT) + (SN) - 1) / (SN), SMT_ = ((MT) + (SM) - 1) / (SM); \
    unsigned* qc_ = (unsigned*)(p.ws + OFF_Q) + (PH * 8 + xcd_) * 16; \
    volatile LAS unsigned* qw_ = (volatile LAS unsigned*)(lds + LDS_BYTES - 8); \
    const bool t0_ = threadIdx.x == 0; unsigned nxt_ = 0u; \
    if (t0_) nxt_ = __hip_atomic_fetch_add(qc_, 1u, __ATOMIC_RELAXED, __HIP_MEMORY_SCOPE_AGENT); \
    for (;;) { __syncthreads(); if (t0_) *qw_ = nxt_; __syncthreads(); \
      const int w_ = __builtin_amdgcn_readfirstlane((int)*qw_); \
      const int s_ = (w_ >> 6) * 8 + xcd_; if (s_ >= SMT_ * SNT_) break; \
      if (t0_) nxt_ = __hip_atomic_fetch_add(qc_, 1u, __ATOMIC_RELAXED, __HIP_MEMORY_SCOPE_AGENT); \
      const int slot_ = w_ & 63; if (slot_ >= (SM) * (SN)) continue; \
      const int tm = (s_ / SNT_) * (SM) + slot_ / (SN), tn = (s_ % SNT_) * (SN) + slot_ % (SN); if (tm >= (MT) || tn >= (NT)) continue; __VA_ARGS__ } }

template <int PH>
DEVI void run_phase(const Params& p, char* lds) {
  unsigned char* ws = p.ws;
  const bf16_t* ACTA = (const bf16_t*)(ws + OFF_ACTA);
  const bf16_t* ACTB = (const bf16_t*)(ws + OFF_ACTB);
  float* ctxr = (float*)(ws + OFF_CTXR);
  if constexpr (PH == 0) phase_prep(p, lds);
  if constexpr (PH == 1) phase_norm(p, p.in[0], p.in[2], p.in[6], 0, 0, 1, NTOK);
  if constexpr (PH == 2) phase_s5_state(p);
  if constexpr (PH == 3) phase_s5_carry(p);
  if constexpr (PH == 4) phase_s5<true>(p, lds);
  if constexpr (PH == 5)
    GEMM_LOOP(264, 16, 8, 8, { gemm_tile<EPI_GLU, false>(p, ACTB, LDP, (const bf16_t*)(ws + OFF_WGLU), LDP, DM, tm * 128, 0, 0, tn, 0, 0, lds); })
  if constexpr (PH == 6) phase_norm(p, p.out, ctxr, p.in[7], 0, 3, 4, NTOK);
  if constexpr (PH == 7)
    GEMM_LOOP(270, 44, 16, 4, {
      const int rb = tm < 261 ? tm * 126 - 1 : NLAT + (tm - 261) * 126 - 1;
      const int lo = tm < 261 ? 0 : NLAT, hi = tm < 261 ? NLAT : NTOK;
      gemm_tile<EPI_FFNIN, true>(p, ACTA, LDP, (const bf16_t*)(ws + OFF_WFIN), LDP, DM, rb, lo, hi, tn, 0, 0, lds);
    })
  if constexpr (PH == 8)
    GEMM_LOOP(264, 8, 8, 8, { gemm_tile<EPI_RES, false>(p, (const bf16_t*)(ws + OFF_X), FF, (const bf16_t*)(ws + OFF_WFOUT), FF, FF, tm * 128, 0, 0, tn, 0, 5, lds); })
  if constexpr (PH == 9) phase_norm(p, p.out, ctxr, p.in[6] + DM, 1, 0, 1, NTOK);
  if constexpr (PH == 10)
    GEMM_LOOP(264, 9, 21, 3, { gemm_tile<EPI_G1, false>(p, ACTA, LDP, (const bf16_t*)(ws + OFF_WD), LDP, DM, tm * 128, 0, 0, tn, 1, 0, lds); })
  if constexpr (PH == 11)
    GEMM_LOOP(256, 12, 16, 4, { gemm_tile<EPI_Q, false>(p, (const bf16_t*)(ws + OFF_Y), 1152, (const bf16_t*)(ws + OFF_WUQ), 768, 768, tm * 128, 0, 0, tn, 1, 0, lds); })
  if constexpr (PH == 12)
    GEMM_LOOP(264, 16, 8, 8, { gemm_tile<EPI_KV, false>(p, (const bf16_t*)(ws + OFF_Y) + 768, 1152, (const bf16_t*)(ws + OFF_WUKV), 256, 256, tm * 128, 0, 0, tn, 1, 0, lds); })
  if constexpr (PH == 13) {
    float sbound;
    {
      const int ln = tid_() & 63;
      float mq = fmaxf(fabsf(p.in[24][ln]), fabsf(p.in[24][64 + ln])), mk = fmaxf(fabsf(p.in[26][ln]), fabsf(p.in[26][64 + ln]));
      float mqr = fabsf(p.in[25][ln]), mkr = fabsf(p.in[27][ln]);
#pragma unroll
      for (int o_ = 32; o_; o_ >>= 1) { mq = fmaxf(mq, __shfl_xor(mq, o_)); mk = fmaxf(mk, __shfl_xor(mk, o_)); mqr = fmaxf(mqr, __shfl_xor(mqr, o_)); mkr = fmaxf(mkr, __shfl_xor(mkr, o_)); }
      sbound = __int_as_float(__builtin_amdgcn_readfirstlane(__float_as_int(ASCALE * (128.f * mq * mk + 64.f * mqr * mkr) * 1.02f)));
    }
    const int xcd_ = blockIdx.x & 7;
    unsigned* qc_ = (unsigned*)(p.ws + OFF_Q) + (PH * 8 + xcd_) * 16;
    volatile LAS unsigned* qw_ = (volatile LAS unsigned*)(lds + LDS_BYTES - 8);
    const bool t0_ = threadIdx.x == 0; unsigned nxt_ = 0u;
    if (t0_) nxt_ = __hip_atomic_fetch_add(qc_, 1u, __ATOMIC_RELAXED, __HIP_MEMORY_SCOPE_AGENT);
    for (;;) {
      __syncthreads(); if (t0_) *qw_ = nxt_; __syncthreads();
      const int w_ = __builtin_amdgcn_readfirstlane((int)*qw_);
      if (w_ >= 256) break;
      if (t0_) nxt_ = __hip_atomic_fetch_add(qc_, 1u, __ATOMIC_RELAXED, __HIP_MEMORY_SCOPE_AGENT);
      const int bh = (w_ >> 6) * 8 + xcd_, qb = w_ & 63;
      const int b = bh >> 3, h = bh & 7;
      const bf16_t* Qp = (const bf16_t*)(ws + OFF_X) + ((size_t)bh * SEQL + qb * 128) * 192;
      const bf16_t* Kp = (const bf16_t*)(ws + OFF_K) + (size_t)bh * KVL * 192;
      const bf16_t* Vp = (const bf16_t*)(ws + OFF_ACTA) + (size_t)bh * KVL * 128;
      bf16_t* Op = (bf16_t*)(ws + OFF_ACTB) + ((size_t)(b * SEQL + qb * 128)) * LDP + h * 128;
      if (sbound <= 60.f) attn_task<true>(Qp, Kp, Vp, Op, lds, -sbound * 1.4426950408889634f);
      else attn_task<false>(Qp, Kp, Vp, Op, lds, 0.f);
    }
  }
  if constexpr (PH == 14)
    GEMM_LOOP(256, 8, 8, 8, { gemm_tile<EPI_RES, false>(p, ACTB, LDP, (const bf16_t*)(ws + OFF_WO), LDP, DM, tm * 128, 0, 0, tn, 1, 2, lds); })
  if constexpr (PH == 15) phase_norm(p, p.out, ctxr, p.in[7] + DM, 1, 3, 4, NLAT);
  if constexpr (PH == 16)
    GEMM_LOOP(261, 44, 16, 4, { gemm_tile<EPI_FFNIN, true>(p, ACTA, LDP, (const bf16_t*)(ws + OFF_WFIN + WFIN_BYTES), LDP, DM, tm * 126 - 1, 0, NLAT, tn, 1, 0, lds); })
  if constexpr (PH == 17)
    GEMM_LOOP(256, 8, 8, 8, { gemm_tile<EPI_RES, false>(p, (const bf16_t*)(ws + OFF_X), FF, (const bf16_t*)(ws + OFF_WFOUT + 5767168), FF, FF, tm * 128, 0, 0, tn, 1, 5, lds); })
}

#ifndef PHMASK
#define PHMASK 0x3ffff
#endif
#ifndef PROBE_MASK
#define PROBE_MASK 0
#endif
#define RUNP(N) do { if ((PHMASK >> N) & 1) { if ((PROBE_MASK >> N) & 1) { for (int r_ = 0; r_ < p.pad0; ++r_) { run_phase<N>(p, lds); SYNCG(); } } else run_phase<N>(p, lds); } } while (0)
#define SYNCG() xcd_barrier(xb)
__global__ void __launch_bounds__(256, 2) mega(Params p) {
  extern __shared__ __attribute__((aligned(16))) char lds[];
  volatile LAS unsigned* xst = (volatile LAS unsigned*)(lds + LDS_BYTES - 16);
  if (threadIdx.x == 0) { xst[0] = 0u; xst[1] = 0u; }
  __syncthreads();
  const XcdBarrier xb = xcd_barrier_post((unsigned*)(p.ws + OFF_BAR), xst);
  if (p.pad1) cg::this_grid().sync();
  RUNP(0); SYNCG(); RUNP(1); SYNCG(); RUNP(2); SYNCG(); RUNP(3); SYNCG(); RUNP(4); SYNCG(); RUNP(5); SYNCG();
  RUNP(6); SYNCG(); RUNP(7); SYNCG(); RUNP(8); SYNCG(); RUNP(9); SYNCG(); RUNP(10); SYNCG(); RUNP(11); RUNP(12); SYNCG();
  RUNP(13); SYNCG(); RUNP(14); SYNCG(); RUNP(15); SYNCG(); RUNP(16); SYNCG(); RUNP(17);
}
template <int PH>
__global__ void __launch_bounds__(256, 2) phase_kernel(Params p) {
  extern __shared__ __attribute__((aligned(16))) char lds[];
  run_phase<PH>(p, lds);
}


extern "C" void kernel_launch(void* const* d_in, const int* in_sizes, int n_in, void* d_out, int out_size, void* d_ws, size_t ws_size, hipStream_t stream) {
  static int grid_blocks = 0;
  if (grid_blocks == 0) {
    if (n_in != 33 || out_size != NLAT * DM || ws_size < WS_END) {
      fprintf(stderr, "kernel_launch: unexpected shapes n_in %d out %d ws %zu (need %zu)\n", n_in, out_size, ws_size, (size_t)WS_END);
      grid_blocks = -1; return;
    }
    int dev = 0, cus = 0, per_cu = 0;
    hipGetDevice(&dev);
    hipDeviceGetAttribute(&cus, hipDeviceAttributeMultiprocessorCount, dev);
    if (hipFuncSetAttribute((const void*)mega, hipFuncAttributeMaxDynamicSharedMemorySize, LDS_BYTES) != hipSuccess) {
      fprintf(stderr, "kernel_launch: hipFuncSetAttribute failed\n"); grid_blocks = -1; return; }
    hipOccupancyMaxActiveBlocksPerMultiprocessor(&per_cu, (const void*)mega, 256, LDS_BYTES);
    if (per_cu < 1) { fprintf(stderr, "kernel_launch: occupancy query returned %d\n", per_cu); per_cu = 1; }
    if (per_cu > 2) per_cu = 2;
    grid_blocks = cus * per_cu;
    (void)hipGetLastError();
  }
  if (grid_blocks < 0) return;
  Params p{};
  for (int i = 0; i < 33; ++i) p.in[i] = (const float*)d_in[i];
  p.out = (float*)d_out; p.ws = (unsigned char*)d_ws; p.pad0 = 2;
#if ONE_LAUNCH
  if (hipMemsetAsync((char*)d_ws + OFF_BAR, 0, 16384 + 18 * 8 * 64, stream) != hipSuccess) { fprintf(stderr, "memset failed\n"); return; }
  void* args[] = {&p};
  hipError_t e = hipLaunchCooperativeKernel((const void*)mega, dim3(grid_blocks), dim3(256), args, LDS_BYTES, stream);
  if (e != hipSuccess) fprintf(stderr, "cooperative launch failed: %s (grid %d)\n", hipGetErrorString(e), grid_blocks);
#else
#define LP(N) hipLaunchKernelGGL(phase_kernel<N>, dim3(grid_blocks), dim3(256), LDS_BYTES, stream, p)
  LP(0); LP(1); LP(2); LP(3); LP(4); LP(5); LP(6); LP(7); LP(8); LP(9); LP(10); LP(11); LP(12); LP(13); LP(14); LP(15); LP(16); LP(17);
#undef LP
#endif
}
```
